# Optimizing an MI355X kernel written in HIP

```python
import math
import jax, jax.numpy as jnp
from jax import lax
import numpy as np

D_MODEL = 1024
BATCH = 16
SEQ = 256
DEPTH = 2
DEC_BATCH = 8
DEC_SEQ = 1024
PAST_LEN = 512

GRID_W = 64
D_MIX = 2 * D_MODEL
A_INNER = D_MIX // 2
A_HEAD_DIM = 64
A_HEADS = A_INNER // A_HEAD_DIM
A_GROUPS = 4
A_HPG = A_HEADS // A_GROUPS
A_D_STATE = 128
A_GN = A_GROUPS * A_D_STATE
A_CONV = 4
A_CONV_CH = A_INNER + 2 * A_GN
A_CHUNK = 128
A_IN = A_INNER + A_CONV_CH + 2 * A_HEADS
B_CH = D_MIX // 2
B_CONV = 31
B_IN = 3 * B_CH
L0_IN = A_IN + B_IN
L0_OUT = A_INNER + B_CH
C_WIDTH = D_MIX
C_GROUPS = 16
C_GROUP_DIM = C_WIDTH // C_GROUPS
C_CHUNK = 128
L1_IN = 3 * C_WIDTH
ALPHA = (2 * DEPTH) ** 0.25
BETA = (8 * DEPTH) ** -0.25
LN_EPS = 1e-5
RMS_EPS = 1e-5
POS_BASE = 10000.0

kernel_name = "hybrid_ssd_conformer_gmlp_diffusion_step"


def layer_norm(x, g, b):
    xf = x.astype(jnp.float32)
    mu = jnp.mean(xf, axis=-1, keepdims=True)
    var = jnp.mean(jnp.square(xf - mu), axis=-1, keepdims=True)
    out = (xf - mu) * lax.rsqrt(var + LN_EPS) * g.astype(jnp.float32) + b.astype(jnp.float32)
    return out.astype(x.dtype)


def depthwise_conv(x, w, bias, pad_lo, pad_hi):
    C = w.shape[1]
    out = lax.conv_general_dilated(
        x, w[:, None, :].astype(x.dtype), window_strides=(1,),
        padding=[(pad_lo, pad_hi)], dimension_numbers=("NWC", "WIO", "NWC"),
        feature_group_count=C)
    return out + bias.astype(x.dtype)


def adaln(cond, w, b):
    m = (jax.nn.silu(cond) @ w + b)[:, None, :]
    return jnp.split(m, 3, axis=-1)


def grid_pos_embed(L, d):
    rows = L // GRID_W
    quarter = d // 4
    freqs = 1.0 / (POS_BASE ** (jnp.arange(quarter, dtype=jnp.float32) / quarter))
    r = jnp.arange(rows, dtype=jnp.float32)[:, None] * freqs
    cc = jnp.arange(GRID_W, dtype=jnp.float32)[:, None] * freqs
    emb_r = jnp.concatenate([jnp.sin(r), jnp.cos(r)], axis=-1)
    emb_c = jnp.concatenate([jnp.sin(cc), jnp.cos(cc)], axis=-1)
    emb = jnp.concatenate([
        jnp.broadcast_to(emb_r[:, None, :], (rows, GRID_W, d // 2)),
        jnp.broadcast_to(emb_c[None, :, :], (rows, GRID_W, d // 2))], axis=-1)
    return emb.reshape(rows * GRID_W, d)


def ssd_chunked_scan(x, dt, a_neg, bm, cm, h0):
    b, L, G, R, P = x.shape
    N = bm.shape[-1]
    nc = L // A_CHUNK
    x = x.reshape(b, nc, A_CHUNK, G, R, P)
    dt = dt.reshape(b, nc, A_CHUNK, G, R)
    bm = bm.reshape(b, nc, A_CHUNK, G, N)
    cm = cm.reshape(b, nc, A_CHUNK, G, N)
    acs = jnp.cumsum(dt * a_neg, axis=2)
    tril = jnp.tril(jnp.ones((A_CHUNK, A_CHUNK), dtype=bool))
    seg = acs[:, :, :, None] - acs[:, :, None, :]
    lmat = jnp.exp(jnp.where(tril[:, :, None, None], seg, -jnp.inf))
    xdt = x * dt[..., None]
    cb = jnp.einsum("bcign,bcjgn->bcijg", cm, bm)
    y_diag = jnp.einsum("bcijg,bcijgr,bcjgrp->bcigrp", cb, lmat, xdt)
    decay_end = jnp.exp(acs[:, :, -1:] - acs)
    chunk_states = jnp.einsum("bcjgn,bcjgr,bcjgrp->bcgrpn", bm, decay_end, xdt)
    chunk_decay = jnp.exp(acs[:, :, -1])

    def step(h, inp):
        dec, st = inp
        return h * dec[..., None, None] + st, h

    h_final, h_in = lax.scan(step, h0, (jnp.moveaxis(chunk_decay, 1, 0), jnp.moveaxis(chunk_states, 1, 0)))
    h_in = jnp.moveaxis(h_in, 0, 1)
    y_off = jnp.einsum("bcign,bcigr,bcgrpn->bcigrp", cm, jnp.exp(acs), h_in)
    return (y_diag + y_off).reshape(b, L, G, R, P), h_final


def ssd_mixer(pa, h0f, h0b, p):
    b, L, _ = pa.shape
    f32 = jnp.float32
    z = pa[..., :A_INNER]
    xbc = pa[..., A_INNER:A_INNER + A_CONV_CH]
    dt_raw = pa[..., A_INNER + A_CONV_CH:].astype(f32)
    xbc = jax.nn.silu(depthwise_conv(xbc, p["a_conv_w"], p["a_conv_b"], A_CONV // 2, A_CONV - 1 - A_CONV // 2)).astype(f32)
    xs = xbc[..., :A_INNER].reshape(b, L, A_GROUPS, A_HPG, A_HEAD_DIM)
    bm = xbc[..., A_INNER:A_INNER + A_GN].reshape(b, L, A_GROUPS, A_D_STATE)
    cm = xbc[..., A_INNER + A_GN:].reshape(b, L, A_GROUPS, A_D_STATE)
    dtf = jax.nn.softplus(dt_raw[..., :A_HEADS] + p["a_dt_bias_f"].astype(f32)).reshape(b, L, A_GROUPS, A_HPG)
    dtb = jax.nn.softplus(dt_raw[..., A_HEADS:] + p["a_dt_bias_b"].astype(f32)).reshape(b, L, A_GROUPS, A_HPG)
    af = -jnp.exp(p["a_log_f"].astype(f32)).reshape(A_GROUPS, A_HPG)
    ab = -jnp.exp(p["a_log_b"].astype(f32)).reshape(A_GROUPS, A_HPG)
    sshape = (b, A_GROUPS, A_HPG, A_HEAD_DIM, A_D_STATE)
    h0f = h0f.astype(f32).reshape(sshape)
    h0b = h0b.astype(f32).reshape(sshape)
    yf, hf = ssd_chunked_scan(xs, dtf, af, bm, cm, h0f)
    rev = lambda t: jnp.flip(t, axis=1)
    yb, hb = ssd_chunked_scan(rev(xs), rev(dtb), ab, rev(bm), rev(cm), h0b)
    y = yf + rev(yb) + p["a_d"].astype(f32).reshape(A_GROUPS, A_HPG)[:, :, None] * xs
    y = y.reshape(b, L, A_INNER) * jax.nn.silu(z.astype(f32))
    yg = y.reshape(b, L, A_GROUPS, A_INNER // A_GROUPS)
    yg = yg * lax.rsqrt(jnp.mean(jnp.square(yg), axis=-1, keepdims=True) + RMS_EPS)
    y = yg.reshape(b, L, A_INNER) * p["a_norm_w"].astype(f32)
    out_shape = (b, A_HEADS, A_HEAD_DIM, A_D_STATE)
    return y.astype(pa.dtype), hf.reshape(out_shape), hb.reshape(out_shape)


def conformer_conv_mixer(pb, p):
    val, glu_gate, gate = jnp.split(pb, 3, axis=-1)
    u = val * jax.nn.sigmoid(glu_gate)
    u = depthwise_conv(u, p["b_conv_w"], p["b_conv_b"], B_CONV // 2, B_CONV // 2)
    u = jax.nn.silu(layer_norm(u, p["b_ln_g"], p["b_ln_b"]))
    return u * jax.nn.silu(gate)


def chunk_gmlp_mixer(pc, p):
    u, v, gate = jnp.split(pc, 3, axis=-1)
    v = layer_norm(v, p["c_ln_g"], p["c_ln_b"])
    b, L, _ = v.shape
    vc = v.reshape(b, L // C_CHUNK, C_CHUNK, C_GROUPS, C_GROUP_DIM)
    s = jnp.einsum("gij,bcjgd->bcigd", p["c_ws"].astype(v.dtype), vc)
    s = s + p["c_bs"].T.astype(v.dtype)[:, :, None]
    s = s.reshape(b, L, C_WIDTH)
    return u * s * jax.nn.silu(gate)


def even_layer(x, cond, h0f, h0b, p):
    shift, scale, gate = adaln(cond, p["ada_w"], p["ada_b"])
    h = x * (1 + scale) + shift
    proj = h @ p["w_in"]
    ya, hf, hb = ssd_mixer(proj[..., :A_IN], h0f, h0b, p)
    yb = conformer_conv_mixer(proj[..., A_IN:], p)
    y = jnp.concatenate([ya, yb], axis=-1) @ p["w_out"]
    x = layer_norm(ALPHA * x + gate * y, p["ln_g"], p["ln_b"])
    return x, hf, hb


def odd_layer(x, cond, p):
    shift, scale, gate = adaln(cond, p["ada_w"], p["ada_b"])
    h = x * (1 + scale) + shift
    y = chunk_gmlp_mixer(h @ p["w_in"], p) @ p["w_out"]
    return layer_norm(ALPHA * x + gate * y, p["ln_g"], p["ln_b"])


def setup_inputs(seed: int = 0) -> dict:
    key = jax.random.key(seed)
    ks = iter(jax.random.split(key, 48))
    nrm = lambda shape, scale: jax.random.normal(next(ks), shape, jnp.float32) * scale

    def dt_bias():
        dt = jnp.exp(jax.random.uniform(next(ks), (A_HEADS,), jnp.float32, math.log(1e-3), math.log(1e-1)))
        return dt + jnp.log(-jnp.expm1(-dt))

    def a_log():
        return jnp.log(jax.random.uniform(next(ks), (A_HEADS,), jnp.float32, 1.0, 16.0))

    d_in = D_MODEL ** -0.5
    return {
        "x_prompt": nrm((BATCH, SEQ, D_MODEL), 1.0),
        "x_sample": nrm((DEC_BATCH, DEC_SEQ, D_MODEL), 1.0),
        "state_ssd_fwd_l0": nrm((DEC_BATCH, A_HEADS, A_HEAD_DIM, A_D_STATE), 0.5),
        "state_ssd_bwd_l0": nrm((DEC_BATCH, A_HEADS, A_HEAD_DIM, A_D_STATE), 0.5),
        "c": nrm((DEC_BATCH, D_MODEL), 1.0),
        "c_ctx": nrm((D_MODEL,), 1.0),
        "ada_w_l0": nrm((D_MODEL, 3 * D_MODEL), d_in),
        "ada_b_l0": nrm((3 * D_MODEL,), 0.02),
        "w_in_l0": nrm((D_MODEL, L0_IN), d_in),
        "a_conv_w_l0": nrm((A_CONV, A_CONV_CH), A_CONV ** -0.5),
        "a_conv_b_l0": nrm((A_CONV_CH,), 0.02),
        "a_dt_bias_f_l0": dt_bias(),
        "a_dt_bias_b_l0": dt_bias(),
        "a_log_f_l0": a_log(),
        "a_log_b_l0": a_log(),
        "a_d_l0": 1.0 + nrm((A_HEADS,), 0.02),
        "a_norm_w_l0": 1.0 + nrm((A_INNER,), 0.02),
        "b_conv_w_l0": nrm((B_CONV, B_CH), B_CONV ** -0.5),
        "b_conv_b_l0": nrm((B_CH,), 0.02),
        "b_ln_g_l0": 1.0 + nrm((B_CH,), 0.02),
        "b_ln_b_l0": nrm((B_CH,), 0.02),
        "w_out_l0": nrm((L0_OUT, D_MODEL), L0_OUT ** -0.5 * BETA),
        "ln_g_l0": 1.0 + nrm((D_MODEL,), 0.02),
        "ln_b_l0": nrm((D_MODEL,), 0.02),
        "ada_w_l1": nrm((D_MODEL, 3 * D_MODEL), d_in),
        "ada_b_l1": nrm((3 * D_MODEL,), 0.02),
        "w_in_l1": nrm((D_MODEL, L1_IN), d_in),
        "c_ln_g_l1": 1.0 + nrm((C_WIDTH,), 0.02),
        "c_ln_b_l1": nrm((C_WIDTH,), 0.02),
        "c_ws_l1": nrm((C_GROUPS, C_CHUNK, C_CHUNK), C_CHUNK ** -0.5),
        "c_bs_l1": 1.0 + nrm((C_GROUPS, C_CHUNK), 0.02),
        "w_out_l1": nrm((C_WIDTH, D_MODEL), C_WIDTH ** -0.5 * BETA),
        "ln_g_l1": 1.0 + nrm((D_MODEL,), 0.02),
        "ln_b_l1": nrm((D_MODEL,), 0.02),
    }


def reference(x_prompt, x_sample, state_ssd_fwd_l0, state_ssd_bwd_l0, c, c_ctx,
              ada_w_l0, ada_b_l0, w_in_l0, a_conv_w_l0, a_conv_b_l0,
              a_dt_bias_f_l0, a_dt_bias_b_l0, a_log_f_l0, a_log_b_l0, a_d_l0, a_norm_w_l0,
              b_conv_w_l0, b_conv_b_l0, b_ln_g_l0, b_ln_b_l0, w_out_l0, ln_g_l0, ln_b_l0,
              ada_w_l1, ada_b_l1, w_in_l1, c_ln_g_l1, c_ln_b_l1, c_ws_l1, c_bs_l1,
              w_out_l1, ln_g_l1, ln_b_l1):
    layers = [
        dict(ada_w=ada_w_l0, ada_b=ada_b_l0, w_in=w_in_l0, a_conv_w=a_conv_w_l0, a_conv_b=a_conv_b_l0,
             a_dt_bias_f=a_dt_bias_f_l0, a_dt_bias_b=a_dt_bias_b_l0, a_log_f=a_log_f_l0, a_log_b=a_log_b_l0,
             a_d=a_d_l0, a_norm_w=a_norm_w_l0, b_conv_w=b_conv_w_l0, b_conv_b=b_conv_b_l0,
             b_ln_g=b_ln_g_l0, b_ln_b=b_ln_b_l0, w_out=w_out_l0, ln_g=ln_g_l0, ln_b=ln_b_l0),
        dict(ada_w=ada_w_l1, ada_b=ada_b_l1, w_in=w_in_l1, c_ln_g=c_ln_g_l1, c_ln_b=c_ln_b_l1,
             c_ws=c_ws_l1, c_bs=c_bs_l1, w_out=w_out_l1, ln_g=ln_g_l1, ln_b=ln_b_l1),
    ]
    cache_states = [(state_ssd_fwd_l0, state_ssd_bwd_l0)]
    cond_ctx = c_ctx[None, :]
    x_p = x_prompt
    x_s = x_sample + grid_pos_embed(x_sample.shape[1], D_MODEL).astype(x_sample.dtype)
    new_states = []
    for i in range(DEPTH):
        p = layers[i]
        if i % 2 == 0:
            zeros = jnp.zeros((x_p.shape[0], A_HEADS, A_HEAD_DIM, A_D_STATE), jnp.float32)
            x_p, hf, hb = even_layer(x_p, cond_ctx, zeros, zeros, p)
            new_states.append((hf, hb))
            cf, cb = cache_states[i // 2]
            x_s, _, _ = even_layer(x_s, c, cf, cb, p)
        else:
            x_p = odd_layer(x_p, cond_ctx, p)
            x_s = odd_layer(x_s, c, p)
    new_ssd_fwd_l0, new_ssd_bwd_l0 = new_states[0]
    return (x_p, x_s, new_ssd_fwd_l0, new_ssd_bwd_l0)
```

```cpp
#include <hip/hip_runtime.h>
#include <hip/hip_cooperative_groups.h>
#include <cstdio>
namespace cg = cooperative_groups;
namespace pg8 {
#define PG8_LAS __attribute__((address_space(3)))
typedef unsigned short bf16_t;
typedef short bf16x8 __attribute__((ext_vector_type(8)));
typedef float f32x4 __attribute__((ext_vector_type(4)));
typedef unsigned u32x4 __attribute__((ext_vector_type(4)));
constexpr int BM = 256, BK = 64, HALF = 128, HTB = HALF * BK * 2  , STAGE_BYTES = 8 * HTB, NXCD = 8, WGM = 8;

__host__ __device__ __forceinline__ int lds_byte(int r, int c) { const int st = (r >> 4) * 2 + (c >> 5), rr = r & 15, cc = c & 31, ob = rr * 64 + cc * 2; return st * 1024 + (ob ^ (((ob >> 9) & 1) << 5)); }
__host__ __device__ __forceinline__ void stage_rc(int b, int& R, int& C) { const int st = b / 1024, sb = b % 1024, swz = sb ^ (((sb >> 9) & 1) << 5); R = (st >> 1) * 16 + swz / 64; C = (st & 1) * 32 + (swz % 64) / 2; }
__host__ __device__ __forceinline__ int perm32(int rho) { const int n = rho >> 4, i = rho & 15; return 8 * (i >> 2) + 4 * n + (i & 3); }

struct Unit { int pm, pn; };
struct Gemm { const bf16_t* A; const bf16_t* Bt; int M, N, K; };

struct StaticOrder {
    int nM, nN, nwg, G, c;
    __host__ __device__ void init(int M, int N, int G_, int c_) { nM = M / BM; nN = N / BM; nwg = nM * nN; G = G_; c = c_; }
    __host__ __device__ bool next(int i, Unit& u) const {
        const long L = (long)i * G + c; if (L >= nwg) return false;
        int wgid = (int)L; { const int q = nwg / NXCD, r = nwg % NXCD, xcd = wgid % NXCD, off = wgid / NXCD; wgid = (xcd < r ? xcd * (q + 1) : r * (q + 1) + (xcd - r) * q) + off; }
        const int nig = WGM * nN, gid = wgid / nig, fm = gid * WGM, gsz = (nM - fm) < WGM ? (nM - fm) : WGM;
        u.pm = fm + ((wgid % nig) % gsz); u.pn = (wgid % nig) / gsz; return true;
    }
    __device__ __forceinline__ void a_ready(const Unit&) const {}
    __device__ __forceinline__ void done(const Unit&) const {}
};
typedef __bf16 bf16x2n_t __attribute__((ext_vector_type(2))); typedef float f32x2n_t __attribute__((ext_vector_type(2)));
__device__ __forceinline__ unsigned cvt_pk_bf16(float lo, float hi) { f32x2n_t v = {lo, hi}; bf16x2n_t r = __builtin_convertvector(v, bf16x2n_t); return __builtin_bit_cast(unsigned, r); }
template <class Epi, class Sched, bool STAMP = false>
__device__ __forceinline__ void gemm_phase(PG8_LAS unsigned char* lds, const Gemm g, const Sched& S, const Epi& E, unsigned long long* stamps) {
    int tid_ = threadIdx.x; asm volatile("" : "+v"(tid_));
    const int tid = tid_, wid = __builtin_amdgcn_readfirstlane(tid >> 6), lane = tid & 63, wr = wid >> 2, wc = wid & 3, fr = lane & 15, fq = lane >> 4;
    const int K = g.K, nt = K / BK;
    int ts_lo = 0, ts_hi = 0, nts = 0; const unsigned long long rt_entry = STAMP ? (unsigned long long)wall_clock64() : 0ull;
#define PG8_STAMP() do { if (STAMP && wid == 0 && nts < 64) { const unsigned long long _c = (unsigned long long)clock64(); \
        ts_lo = (lane == nts) ? (int)(unsigned)_c : ts_lo; ts_hi = (lane == nts) ? (int)(unsigned)(_c >> 32) : ts_hi; ++nts; } } while (0)
    PG8_STAMP();
    unsigned voffA[2], voffB[2];
#pragma unroll
    for (int i = 0; i < 2; ++i) { int R, C; stage_rc(tid * 16 + i * 8192, R, C); const int Rb = Epi::PERM ? ((R & ~31) + perm32(R & 31)) : R;
        voffA[i] = (unsigned)(R * K + C) * 2u; voffB[i] = (unsigned)(Rb * K + C) * 2u; }
    const size_t kstep = (size_t)(BK * 2);
    const size_t hstep = (size_t)HALF * K * 2;
    const size_t tstep = 2 * hstep;
    const unsigned ldsw = (unsigned)wid * 1024u;
    const int aoff = lds_byte(wr * 64 + fr, fq * 8), boff = lds_byte(wc * 32 + fr, fq * 8);
#define PG8_SA(b, h) (((b) * 2 + (h)) * HTB)
#define PG8_SB(b, h) ((4 + (b) * 2 + (h)) * HTB)
#define PG8_STAGE(bufoff, gbase, voff) do { _Pragma("unroll") for (int _i = 0; _i < 2; ++_i) \
        __builtin_amdgcn_global_load_lds((const unsigned*)((const char*)(gbase) + (voff)[_i]), (PG8_LAS unsigned*)(lds + (bufoff) + ldsw + _i * 8192), 16, 0, 0); } while (0)
#define PG8_LDA(dst, b, h) do { _Pragma("unroll") for (int m = 0; m < 4; ++m) _Pragma("unroll") for (int k = 0; k < 2; ++k) dst[m][k] = *(const PG8_LAS bf16x8*)(lds + PG8_SA(b, h) + aoff + m * 2048 + k * 1024); } while (0)
#define PG8_LDB(dst, b, h) do { _Pragma("unroll") for (int n = 0; n < 2; ++n) _Pragma("unroll") for (int k = 0; k < 2; ++k) dst[n][k] = *(const PG8_LAS bf16x8*)(lds + PG8_SB(b, h) + boff + n * 2048 + k * 1024); } while (0)
#define PG8_MMA(ai, bj, At, Bt) do { __builtin_amdgcn_s_setprio(1); _Pragma("unroll") for (int m = 0; m < 4; ++m) _Pragma("unroll") for (int n = 0; n < 2; ++n) _Pragma("unroll") for (int k = 0; k < 2; ++k) \
        acc[ai][bj][m][n] = __builtin_amdgcn_mfma_f32_16x16x32_bf16(Bt[n][k], At[m][k], acc[ai][bj][m][n], 0, 0, 0); __builtin_amdgcn_s_setprio(0); } while (0)
#define PG8_WAIT_V(n) asm volatile("s_waitcnt vmcnt(" #n ")" ::: "memory")
#define PG8_WAIT_L(n) asm volatile("s_waitcnt lgkmcnt(" #n ")" ::: "memory")
#define PG8_BAR __builtin_amdgcn_s_barrier()
#define PG8_SCHED __builtin_amdgcn_sched_barrier(0)
    Unit cur, nxt; int ui = 0;
    if (!S.next(0, cur)) return;
    f32x4 acc[2][2][4][2];
#pragma unroll
    for (int a = 0; a < 2; ++a)
#pragma unroll
        for (int b = 0; b < 2; ++b)
#pragma unroll
            for (int m = 0; m < 4; ++m)
#pragma unroll
                for (int n = 0; n < 2; ++n) acc[a][b][m][n] = (f32x4){0.f, 0.f, 0.f, 0.f};
    bf16x8 At[4][2], B0[2][2], B1[2][2];
    const char* cA = (const char*)g.A + (size_t)cur.pm * tstep; const char* cB = (const char*)g.Bt + (size_t)cur.pn * tstep;
    S.a_ready(cur);
    PG8_STAGE(PG8_SB(0, 0), cB, voffB); PG8_STAGE(PG8_SA(0, 0), cA, voffA); PG8_STAGE(PG8_SB(0, 1), cB + hstep, voffB); PG8_STAGE(PG8_SA(0, 1), cA + hstep, voffA);
    if (wr == 1) PG8_BAR;
    PG8_WAIT_V(4); PG8_BAR;
    PG8_STAGE(PG8_SB(1, 0), cB + kstep, voffB); PG8_STAGE(PG8_SA(1, 0), cA + kstep, voffA); PG8_STAGE(PG8_SB(1, 1), cB + hstep + kstep, voffB);
    PG8_WAIT_V(6); PG8_BAR;
    PG8_STAMP();
    for (;;) {
        const bool has_next = S.next(ui + 1, nxt);
        const char* nA = has_next ? (const char*)g.A + (size_t)nxt.pm * tstep : cA; const char* nB = has_next ? (const char*)g.Bt + (size_t)nxt.pn * tstep : cB;
        for (int t = 0; t < nt; t += 2) {
            const bool last = (t == nt - 2);
            const char* a1 = cA + (size_t)(t + 1) * kstep;
            const char* a2 = last ? nA : cA + (size_t)(t + 2) * kstep; const char* b2 = last ? nB : cB + (size_t)(t + 2) * kstep;
            const char* a3 = a2 + kstep; const char* b3 = b2 + kstep;
            if (last && has_next) S.a_ready(nxt);
            PG8_LDB(B0, 0, 0); PG8_SCHED; PG8_LDA(At, 0, 0); PG8_STAGE(PG8_SA(1, 1), a1 + hstep, voffA);
            PG8_WAIT_L(8); PG8_BAR; PG8_WAIT_L(0); PG8_MMA(0, 0, At, B0); PG8_BAR; PG8_SCHED;
            PG8_LDB(B1, 0, 1); PG8_STAGE(PG8_SB(0, 0), b2, voffB);
            PG8_BAR; PG8_WAIT_L(0); PG8_MMA(0, 1, At, B1); PG8_BAR;
            PG8_LDA(At, 0, 1); PG8_STAGE(PG8_SA(0, 0), a2, voffA);
            PG8_BAR; PG8_WAIT_L(0); PG8_MMA(1, 0, At, B0); PG8_BAR; PG8_SCHED;
            PG8_STAGE(PG8_SB(0, 1), b2 + hstep, voffB);
            PG8_WAIT_V(6); PG8_BAR; PG8_MMA(1, 1, At, B1); PG8_BAR;
            PG8_LDB(B0, 1, 0); PG8_SCHED; PG8_LDA(At, 1, 0); PG8_STAGE(PG8_SA(0, 1), a2 + hstep, voffA);
            PG8_WAIT_L(8); PG8_BAR; PG8_WAIT_L(0); PG8_MMA(0, 0, At, B0); PG8_BAR; PG8_SCHED;
            PG8_LDB(B1, 1, 1); PG8_STAGE(PG8_SB(1, 0), b3, voffB);
            PG8_BAR; PG8_WAIT_L(0); PG8_MMA(0, 1, At, B1); PG8_BAR;
            PG8_LDA(At, 1, 1); PG8_STAGE(PG8_SA(1, 0), a3, voffA);
            PG8_BAR; PG8_WAIT_L(0); PG8_MMA(1, 0, At, B0); PG8_BAR; PG8_SCHED;
            PG8_STAGE(PG8_SB(1, 1), b3 + hstep, voffB);
            PG8_WAIT_V(6); PG8_BAR; PG8_MMA(1, 1, At, B1); PG8_BAR;
        }
        PG8_STAMP();
        if constexpr (!Epi::AFTER_DRAIN) { E(acc, cur, wr, wc, fr, fq); S.done(cur); }
        PG8_STAMP();
        if (!has_next) break;
#pragma unroll
        for (int a = 0; a < 2; ++a)
#pragma unroll
            for (int b = 0; b < 2; ++b)
#pragma unroll
                for (int m = 0; m < 4; ++m)
#pragma unroll
                    for (int n = 0; n < 2; ++n) acc[a][b][m][n] = (f32x4){0.f, 0.f, 0.f, 0.f};
        cur = nxt; cA = nA; cB = nB; ++ui;
    }
    PG8_WAIT_V(0);
    if (wr == 0) PG8_BAR;
    PG8_BAR;
    if constexpr (Epi::AFTER_DRAIN) { E.fused(acc, cur, wr, wc, fr, fq, lds, wid, lane); S.done(cur); }
    PG8_STAMP();
    if (STAMP && wid == 0) { stamps[lane] = lane < nts ? (((unsigned long long)(unsigned)ts_hi << 32) | (unsigned)ts_lo) : 0ull;
        if (lane == 62) stamps[62] = rt_entry; if (lane == 63) stamps[63] = (unsigned long long)wall_clock64(); }
#undef PG8_STAMP
#undef PG8_SA
#undef PG8_SB
#undef PG8_STAGE
#undef PG8_LDA
#undef PG8_LDB
#undef PG8_MMA
#undef PG8_WAIT_V
#undef PG8_WAIT_L
#undef PG8_BAR
#undef PG8_SCHED
}
}

using pg8::bf16x8; using pg8::f32x4; using pg8::u32x4;
typedef unsigned short bf16_t;
typedef unsigned u32x2 __attribute__((ext_vector_type(2)));
typedef float f32x2v __attribute__((ext_vector_type(2)));

struct Params { const float* in[34]; float* out; unsigned char* ws; };

constexpr int NTOK = 12288;
constexpr size_t OFF_WT0 = 0, OFF_WO0 = 13107200, OFF_WT1 = 17301504, OFF_WO1 = 29884416, OFF_H = 34078720, OFF_P = 59244544,
                 OFF_YC = 210239488, OFF_DT = 260571136, OFF_MODS = 263716864, OFF_POSR = 263938048, OFF_POSC = 263970816, OFF_DEC = 264101888;
constexpr size_t OUT_STF = 12582912, OUT_STB = 14680064;
constexpr float ALPHA_C = 1.41421356237f;
constexpr int LDP = 136;

__device__ __forceinline__ float bf2f(unsigned short b) { return __uint_as_float(((unsigned)b) << 16); }
__device__ __forceinline__ float bflo(unsigned u) { return __uint_as_float(u << 16); }
__device__ __forceinline__ float bfhi(unsigned u) { return __uint_as_float(u & 0xffff0000u); }
__device__ __forceinline__ unsigned pk2(float lo, float hi) { return pg8::cvt_pk_bf16(lo, hi); }
__device__ __forceinline__ float silu_f(float x) { return x / (1.f + __expf(-x)); }
__device__ __forceinline__ float sigmoid_f(float x) { return 1.f / (1.f + __expf(-x)); }
__device__ __forceinline__ float softplus_f(float x) { return x > 20.f ? x : log1pf(expf(x)); }
__device__ __forceinline__ f32x4 mfma16(bf16x8 a, bf16x8 b, f32x4 c) { return __builtin_amdgcn_mfma_f32_16x16x32_bf16(a, b, c, 0, 0, 0); }
__device__ __forceinline__ void unpack8(u32x4 v, float (&o)[8]) { o[0] = bflo(v.x); o[1] = bfhi(v.x); o[2] = bflo(v.y); o[3] = bfhi(v.y); o[4] = bflo(v.z); o[5] = bfhi(v.z); o[6] = bflo(v.w); o[7] = bfhi(v.w); }
__device__ __forceinline__ int opaque_tid() { int t = threadIdx.x; asm volatile("" : "+v"(t)); return t; }
__device__ __forceinline__ int cond_of_row(int r) { return r < 4096 ? 0 : 1 + ((r - 4096) >> 10); }

__device__ void phase_prep(const Params& p, unsigned char* smem) {
    float* sc = (float*)smem;
    float* red = sc + 9 * 1024;
    float* MODS = (float*)(p.ws + OFF_MODS);
    const int tid = opaque_tid();
    bool filled = false;
    for (int u = blockIdx.x; u < 192; u += gridDim.x) {
        if (!filled) {
            for (int e = tid; e < 9 * 1024; e += 512) { const int j = e >> 10, k = e & 1023; const float v = (j == 0) ? p.in[5][k] : p.in[4][(j - 1) * 1024 + k]; sc[e] = silu_f(v); }
            __syncthreads(); filled = true;
        }
        const int layer = u / 96, cb = u % 96;
        const float* W = p.in[layer ? 24 : 6]; const float* bias = p.in[layer ? 25 : 7];
        const int col = cb * 32 + (tid & 31), kg = tid >> 5;
        float acc[9];
#pragma unroll
        for (int j = 0; j < 9; ++j) acc[j] = 0.f;
#pragma unroll 8
        for (int kk = 0; kk < 64; ++kk) { const int k = kg * 64 + kk; const float w = W[(size_t)k * 3072 + col];
#pragma unroll
            for (int j = 0; j < 9; ++j) acc[j] = fmaf(sc[j * 1024 + k], w, acc[j]); }
#pragma unroll
        for (int j = 0; j < 9; ++j) red[(kg * 9 + j) * 32 + (tid & 31)] = acc[j];
        __syncthreads();
        if (tid < 288) { const int j = tid >> 5, c = tid & 31; float s = 0.f;
#pragma unroll
            for (int k2 = 0; k2 < 16; ++k2) s += red[(k2 * 9 + j) * 32 + c];
            MODS[(layer * 9 + j) * 3072 + cb * 32 + c] = s + bias[cb * 32 + c]; }
        __syncthreads();
    }
    float* POSR = (float*)(p.ws + OFF_POSR); float* POSC = (float*)(p.ws + OFF_POSC);
    for (int e = blockIdx.x * 512 + tid; e < 80 * 512; e += gridDim.x * 512) {
        const int pos = e >> 9, d = e & 511, i = d & 255;
        const float freq = exp2f(-(float)i * (13.287712379549449f / 256.f));
        const float arg = (float)(pos < 16 ? pos : pos - 16) * freq;
        const float v = d < 256 ? sinf(arg) : cosf(arg);
        if (pos < 16) POSR[pos * 512 + d] = v; else POSC[(pos - 16) * 512 + d] = v;
    }
}

template <int WHICH> __device__ __forceinline__ void transpose_tiles(const float* __restrict__ src, bf16_t* __restrict__ dst, float* tile) {
    constexpr int K = (WHICH == 0 || WHICH == 2) ? 1024 : 2048, Nsrc = WHICH == 0 ? 6176 : (WHICH == 2 ? 6144 : 1024), Ndst = WHICH == 0 ? 6400 : Nsrc;
    constexpr int nkt = K / 64, ntiles = (Ndst / 64) * nkt;
    const int tid = opaque_tid();
    for (int tt = blockIdx.x; tt < ntiles; tt += gridDim.x) {
        const int ntile = tt / nkt, ktile = tt % nkt;
#pragma unroll
        for (int i = 0; i < 2; ++i) {
            const int k = (tid >> 4) + 32 * i, nd = ntile * 64 + (tid & 15) * 4; int ns = nd; bool ok = true;
            if (WHICH == 0) { if (nd < 3072) ns = nd; else if (nd < 6144) ns = nd + 32; else if (nd < 6176) ns = nd - 3072; else ok = false; }
            f32x4 v = (f32x4){0.f, 0.f, 0.f, 0.f};
            if (ok) v = *(const f32x4*)(src + (size_t)(ktile * 64 + k) * Nsrc + ns);
            float* tp = tile + k * 65 + (tid & 15) * 4; tp[0] = v[0]; tp[1] = v[1]; tp[2] = v[2]; tp[3] = v[3];
        }
        __syncthreads();
        { const int n = tid >> 3, k8 = (tid & 7) * 8;
          const float e0 = tile[(k8 + 0) * 65 + n], e1 = tile[(k8 + 1) * 65 + n], e2 = tile[(k8 + 2) * 65 + n], e3 = tile[(k8 + 3) * 65 + n];
          const float e4 = tile[(k8 + 4) * 65 + n], e5 = tile[(k8 + 5) * 65 + n], e6 = tile[(k8 + 6) * 65 + n], e7 = tile[(k8 + 7) * 65 + n];
          u32x4 o; o.x = pk2(e0, e1); o.y = pk2(e2, e3); o.z = pk2(e4, e5); o.w = pk2(e6, e7);
          *(u32x4*)(dst + (size_t)(ntile * 64 + n) * K + ktile * 64 + k8) = o; }
        __syncthreads();
    }
}
__device__ void phase_conv_h0(const Params& p, unsigned char* smem) {
    float* tile = (float*)smem;
    const int tid = opaque_tid();
    transpose_tiles<0>(p.in[8], (bf16_t*)(p.ws + OFF_WT0), tile);
    transpose_tiles<1>(p.in[21], (bf16_t*)(p.ws + OFF_WO0), tile);
    transpose_tiles<2>(p.in[26], (bf16_t*)(p.ws + OFF_WT1), tile);
    transpose_tiles<3>(p.in[31], (bf16_t*)(p.ws + OFF_WO1), tile);
    const float* MODS = (const float*)(p.ws + OFF_MODS); const float* POSR = (const float*)(p.ws + OFF_POSR); const float* POSC = (const float*)(p.ws + OFF_POSC);
    bf16_t* H = (bf16_t*)(p.ws + OFF_H);
    const int wave = tid >> 6, lane = tid & 63;
    for (int r = blockIdx.x * 8 + wave; r < NTOK; r += gridDim.x * 8) {
        const int cond = cond_of_row(r);
        const float* shift = MODS + cond * 3072; const float* scale = shift + 1024;
        const float* xr = r < 4096 ? p.in[0] + (size_t)r * 1024 : p.in[1] + (size_t)(r - 4096) * 1024;
        const int l = (r - 4096) & 1023;
#pragma unroll
        for (int i = 0; i < 4; ++i) {
            const int c = lane * 4 + 256 * i;
            f32x4 x = *(const f32x4*)(xr + c);
            if (r >= 4096) { const float* pe = c < 512 ? POSR + (l >> 6) * 512 + c : POSC + (l & 63) * 512 + (c - 512); x += *(const f32x4*)pe; }
            const f32x4 s = *(const f32x4*)(scale + c), sh = *(const f32x4*)(shift + c);
            const f32x4 h = x * (s + 1.0f) + sh;
            u32x2 o; o.x = pk2(h[0], h[1]); o.y = pk2(h[2], h[3]);
            *(u32x2*)(H + (size_t)r * 1024 + c) = o;
        }
    }
}

struct EpiIn {
    static constexpr bool PERM = true, AFTER_DRAIN = false;
    bf16_t* P; float* DT; float* LNP;
    __device__ __forceinline__ void operator()(const f32x4 (&acc)[2][2][4][2], const pg8::Unit& u, int wr, int wc, int fr, int fq) const {
        const int row0 = u.pm * 256 + wr * 64 + fr;
        if (u.pn < 24) {
            const int col0 = u.pn * 256 + wc * 32 + 8 * fq;
#pragma unroll
            for (int ai = 0; ai < 2; ++ai)
#pragma unroll
                for (int m = 0; m < 4; ++m) { bf16_t* rowp = P + (size_t)(row0 + ai * 128 + m * 16) * 6144 + col0;
#pragma unroll
                    for (int bj = 0; bj < 2; ++bj) { const f32x4 v0 = acc[ai][bj][m][0], v1 = acc[ai][bj][m][1];
                        u32x4 w; w.x = pk2(v0[0], v0[1]); w.y = pk2(v0[2], v0[3]); w.z = pk2(v1[0], v1[1]); w.w = pk2(v1[2], v1[3]);
                        *(u32x4*)(rowp + bj * 128) = w; } }
            if (LNP != nullptr && u.pn >= 8 && u.pn < 16) {
#pragma unroll
                for (int ai = 0; ai < 2; ++ai)
#pragma unroll
                    for (int m = 0; m < 4; ++m) { float s1 = 0.f, s2 = 0.f;
#pragma unroll
                        for (int bj = 0; bj < 2; ++bj)
#pragma unroll
                            for (int n = 0; n < 2; ++n)
#pragma unroll
                                for (int e = 0; e < 4; ++e) { const float v = acc[ai][bj][m][n][e]; s1 += v; s2 = fmaf(v, v, s2); }
                        s1 += __shfl_xor(s1, 16); s2 += __shfl_xor(s2, 16); s1 += __shfl_xor(s1, 32); s2 += __shfl_xor(s2, 32);
                        if (fq == 0) { f32x2v o; o.x = s1; o.y = s2; *(f32x2v*)(LNP + ((size_t)(row0 + ai * 128 + m * 16) * 32 + (u.pn - 8) * 4 + wc) * 2) = o; } }
            }
        } else if (wc == 0) {
#pragma unroll
            for (int ai = 0; ai < 2; ++ai)
#pragma unroll
                for (int m = 0; m < 4; ++m) { float* rowp = DT + (size_t)(row0 + ai * 128 + m * 16) * 32 + 8 * fq;
                    *(f32x4*)rowp = acc[ai][0][m][0]; *(f32x4*)(rowp + 4) = acc[ai][0][m][1]; }
        }
    }
};
struct EpiOut {
    static constexpr bool PERM = false, AFTER_DRAIN = false;
    float* R; const float* xp; const float* xs; const float* posr; const float* posc; const float* gate; int layer;
    __device__ __forceinline__ void operator()(const f32x4 (&acc)[2][2][4][2], const pg8::Unit& u, int wr, int wc, int fr, int fq) const {
        const int row0 = u.pm * 256 + wr * 64 + fr, col0 = u.pn * 256 + wc * 32 + 4 * fq;
        const int cond = u.pm < 16 ? 0 : 1 + ((u.pm - 16) >> 2);
        f32x4 gv[2][2];
#pragma unroll
        for (int bj = 0; bj < 2; ++bj)
#pragma unroll
            for (int n = 0; n < 2; ++n) gv[bj][n] = *(const f32x4*)(gate + cond * 3072 + col0 + bj * 128 + n * 16);
#pragma unroll
        for (int ai = 0; ai < 2; ++ai)
#pragma unroll
            for (int m = 0; m < 4; ++m) { const int row = row0 + ai * 128 + m * 16;
#pragma unroll
                for (int bj = 0; bj < 2; ++bj)
#pragma unroll
                    for (int n = 0; n < 2; ++n) { const int c = col0 + bj * 128 + n * 16; f32x4 x;
                        if (layer == 0) {
                            if (row < 4096) x = *(const f32x4*)(xp + (size_t)row * 1024 + c);
                            else { x = *(const f32x4*)(xs + (size_t)(row - 4096) * 1024 + c); const int l = (row - 4096) & 1023;
                                const float* pe = c < 512 ? posr + (l >> 6) * 512 + c : posc + (l & 63) * 512 + (c - 512); x += *(const f32x4*)pe; }
                        } else x = *(const f32x4*)(R + (size_t)row * 1024 + c);
                        *(f32x4*)(R + (size_t)row * 1024 + c) = x * ALPHA_C + gv[bj][n] * acc[ai][bj][m][n]; } }
    }
};

__device__ void conformer_unit(const Params& p, unsigned char* smem, int unit) {
    const int tid = opaque_tid(), row_base = unit * 16;
    int seq0, L; if (row_base < 4096) { seq0 = row_base & ~255; L = 256; } else { seq0 = 4096 + ((row_base - 4096) & ~1023); L = 1024; }
    const int t0 = row_base - seq0, c0 = tid * 2;
    const bf16_t* P = (const bf16_t*)(p.ws + OFF_P); bf16_t* YC = (bf16_t*)(p.ws + OFF_YC);
    float w[31][2];
#pragma unroll
    for (int k = 0; k < 31; ++k) { const f32x2v v = *(const f32x2v*)(p.in[17] + k * 1024 + c0); w[k][0] = v.x; w[k][1] = v.y; }
    float acc[16][2];
    { const f32x2v b = *(const f32x2v*)(p.in[18] + c0);
#pragma unroll
      for (int tt = 0; tt < 16; ++tt) { acc[tt][0] = b.x; acc[tt][1] = b.y; } }
    const bf16_t* Pv = P + 3072 + c0; const bf16_t* Pg = P + 4096 + c0;
#pragma unroll
    for (int jr = 0; jr < 46; ++jr) {
        const int t = t0 - 15 + jr; float u0 = 0.f, u1 = 0.f;
        if (t >= 0 && t < L) { const size_t off = (size_t)(seq0 + t) * 6144; const unsigned v = *(const unsigned*)(Pv + off), g = *(const unsigned*)(Pg + off);
            u0 = bflo(v) * sigmoid_f(bflo(g)); u1 = bfhi(v) * sigmoid_f(bfhi(g)); }
#pragma unroll
        for (int tt = 0; tt < 16; ++tt) { const int k = jr - tt; if (k >= 0 && k < 31) { acc[tt][0] = fmaf(w[k][0], u0, acc[tt][0]); acc[tt][1] = fmaf(w[k][1], u1, acc[tt][1]); } }
    }
    float* red1 = (float*)smem; float* red2 = red1 + 16 * 512; float* stat = red2 + 16 * 512;
#pragma unroll
    for (int tt = 0; tt < 16; ++tt) { red1[tt * 512 + tid] = acc[tt][0] + acc[tt][1]; red2[tt * 512 + tid] = acc[tt][0] * acc[tt][0] + acc[tt][1] * acc[tt][1]; }
    __syncthreads();
    { const int tt = tid >> 5, q = tid & 31; float s1 = 0.f, s2 = 0.f;
#pragma unroll
      for (int i = 0; i < 16; ++i) { s1 += red1[tt * 512 + q + 32 * i]; s2 += red2[tt * 512 + q + 32 * i]; }
#pragma unroll
      for (int o = 1; o < 32; o <<= 1) { s1 += __shfl_xor(s1, o); s2 += __shfl_xor(s2, o); }
      const float mean = s1 * (1.f / 1024.f), var = fmaxf(s2 * (1.f / 1024.f) - mean * mean, 0.f);
      if (q == 0) { stat[tt * 2] = mean; stat[tt * 2 + 1] = rsqrtf(var + 1e-5f); } }
    __syncthreads();
    const f32x2v lg = *(const f32x2v*)(p.in[19] + c0), lb = *(const f32x2v*)(p.in[20] + c0);
#pragma unroll
    for (int tt = 0; tt < 16; ++tt) {
        const int row = row_base + tt; const float mean = stat[tt * 2], rstd = stat[tt * 2 + 1];
        const unsigned gt = *(const unsigned*)(P + (size_t)row * 6144 + 5120 + c0);
        float v0 = (acc[tt][0] - mean) * rstd * lg.x + lb.x, v1 = (acc[tt][1] - mean) * rstd * lg.y + lb.y;
        v0 = silu_f(v0) * silu_f(bflo(gt)); v1 = silu_f(v1) * silu_f(bfhi(gt));
        *(unsigned*)(YC + (size_t)row * 2048 + 1024 + c0) = pk2(v0, v1);
    }
    __syncthreads();
}

__device__ __forceinline__ void dt_scan(const Params& p, float* vdt, float* vcum, int row0, int g) {
    const int tid = opaque_tid(); const int wave = tid >> 6, lane = tid & 63, hh = wave >> 1, dir = wave & 1, h = g * 4 + hh;
    const float bias = p.in[dir ? 12 : 11][h], a = -expf(p.in[dir ? 14 : 13][h]);
    const float* DT = (const float*)(p.ws + OFF_DT) + (size_t)row0 * 32 + dir * 16 + h;
    const float d0 = softplus_f(DT[(2 * lane) * 32] + bias), d1 = softplus_f(DT[(2 * lane + 1) * 32] + bias);
    const float v0 = d0 * a, v1 = d1 * a, s = v0 + v1;
    float inc = s;
#pragma unroll
    for (int o = 1; o < 64; o <<= 1) { const float t = __shfl_up(inc, o); if (lane >= o) inc += t; }
    const float exc = inc - s, P0 = exc + v0;
    float* cd = vcum + (hh * 2 + dir) * 128; float* dd = vdt + (hh * 2 + dir) * 128;
    if (dir == 0) { cd[2 * lane] = P0; cd[2 * lane + 1] = inc; }
    else { const float total = __shfl(inc, 63); cd[2 * lane] = total - exc; cd[2 * lane + 1] = total - P0; }
    dd[2 * lane] = d0; dd[2 * lane + 1] = d1;
}
__device__ __forceinline__ void conv_block4(const Params& p, const bf16_t* P, int seq0, int L, int row0, int j0, int cc0, float (&out)[4][8]) {
    const float* cw = p.in[9] + cc0; const float* cbp = p.in[10] + cc0;
    float w[4][8], b[8];
#pragma unroll
    for (int k = 0; k < 4; ++k) { const f32x4 a = *(const f32x4*)(cw + k * 2048), c = *(const f32x4*)(cw + k * 2048 + 4);
        w[k][0] = a[0]; w[k][1] = a[1]; w[k][2] = a[2]; w[k][3] = a[3]; w[k][4] = c[0]; w[k][5] = c[1]; w[k][6] = c[2]; w[k][7] = c[3]; }
    { const f32x4 a = *(const f32x4*)cbp, c = *(const f32x4*)(cbp + 4); b[0] = a[0]; b[1] = a[1]; b[2] = a[2]; b[3] = a[3]; b[4] = c[0]; b[5] = c[1]; b[6] = c[2]; b[7] = c[3]; }
    u32x4 raw[7];
#pragma unroll
    for (int rr = 0; rr < 7; ++rr) { const int grow = row0 + j0 - 2 + rr; raw[rr] = (u32x4){0u, 0u, 0u, 0u};
        if (grow >= seq0 && grow < seq0 + L) raw[rr] = *(const u32x4*)(P + (size_t)grow * 6144 + 1024 + cc0); }
#pragma unroll
    for (int jj = 0; jj < 4; ++jj) {
        float a[8];
#pragma unroll
        for (int e = 0; e < 8; ++e) a[e] = b[e];
#pragma unroll
        for (int k = 0; k < 4; ++k) { float x[8]; unpack8(raw[jj + k], x);
#pragma unroll
            for (int e = 0; e < 8; ++e) a[e] = fmaf(w[k][e], x[e], a[e]); }
#pragma unroll
        for (int e = 0; e < 8; ++e) out[jj][e] = silu_f(a[e]);
    }
}
__device__ __forceinline__ void seq_of_row(int row0, int& seq0, int& L) { if (row0 < 4096) { seq0 = row0 & ~255; L = 256; } else { seq0 = 4096 + ((row0 - 4096) & ~1023); L = 1024; } }

__device__ void sstate_unit(const Params& p, unsigned char* smem, int unit) {
    const int tid = opaque_tid(), wave = tid >> 6, lane = tid & 63, fr = lane & 15, fq = lane >> 4;
    const int cgi = unit >> 2, g = unit & 3, row0 = cgi * 128; int seq0, L; seq_of_row(row0, seq0, L);
    const bf16_t* P = (const bf16_t*)(p.ws + OFF_P); bf16_t* SST = (bf16_t*)p.out; float* DEC = (float*)(p.ws + OFF_DEC);
    bf16_t* BT = (bf16_t*)smem; bf16_t* XTf = BT + 128 * LDP; bf16_t* XTb = XTf + 128 * LDP; float* vdt = (float*)(smem + 104448); float* vcum = (float*)(smem + 108544);
    dt_scan(p, vdt, vcum, row0, g);
    __syncthreads();
    if (tid < 8) { const int hh = tid >> 1, dir = tid & 1; DEC[(cgi * 16 + g * 4 + hh) * 2 + dir] = expf(dir == 0 ? vcum[(hh * 2) * 128 + 127] : vcum[(hh * 2 + 1) * 128]); }
    for (int pair = 0; pair < 2; ++pair) {
        if (pair) __syncthreads();
        { const int chl = (tid & 15) * 8, j0 = (tid >> 4) * 4;
          if (pair == 0) {
              float o[4][8]; conv_block4(p, P, seq0, L, row0, j0, 1024 + g * 128 + chl, o);
#pragma unroll
              for (int e = 0; e < 8; ++e) { u32x2 a; a.x = pk2(o[0][e], o[1][e]); a.y = pk2(o[2][e], o[3][e]); *(u32x2*)(BT + (chl + e) * LDP + j0) = a; }
          }
          const int hh = pair * 2 + (chl >> 6);
          float o[4][8]; conv_block4(p, P, seq0, L, row0, j0, g * 256 + pair * 128 + chl, o);
          float wf[4], wb[4]; const float pf127 = vcum[(hh * 2) * 128 + 127], sb0 = vcum[(hh * 2 + 1) * 128];
#pragma unroll
          for (int jj = 0; jj < 4; ++jj) { wf[jj] = vdt[(hh * 2) * 128 + j0 + jj] * __expf(pf127 - vcum[(hh * 2) * 128 + j0 + jj]); wb[jj] = vdt[(hh * 2 + 1) * 128 + j0 + jj] * __expf(sb0 - vcum[(hh * 2 + 1) * 128 + j0 + jj]); }
#pragma unroll
          for (int e = 0; e < 8; ++e) { u32x2 a, c;
              a.x = pk2(o[0][e] * wf[0], o[1][e] * wf[1]); a.y = pk2(o[2][e] * wf[2], o[3][e] * wf[3]);
              c.x = pk2(o[0][e] * wb[0], o[1][e] * wb[1]); c.y = pk2(o[2][e] * wb[2], o[3][e] * wb[3]);
              *(u32x2*)(XTf + (chl + e) * LDP + j0) = a; *(u32x2*)(XTb + (chl + e) * LDP + j0) = c; }
        }
        __syncthreads();
        const int hd = wave >> 1, hl = hd >> 1, dir = hd & 1, nhalf = wave & 1;
        const bf16_t* XT = (dir ? XTb : XTf) + hl * 64 * LDP;
        f32x4 acc[4][4];
#pragma unroll
        for (int m = 0; m < 4; ++m)
#pragma unroll
            for (int nt = 0; nt < 4; ++nt) acc[m][nt] = (f32x4){0.f, 0.f, 0.f, 0.f};
#pragma unroll
        for (int ks = 0; ks < 4; ++ks) { bf16x8 a[4], b[4];
#pragma unroll
            for (int m = 0; m < 4; ++m) a[m] = *(const bf16x8*)(XT + (m * 16 + fr) * LDP + ks * 32 + fq * 8);
#pragma unroll
            for (int nt = 0; nt < 4; ++nt) b[nt] = *(const bf16x8*)(BT + (nhalf * 64 + nt * 16 + fr) * LDP + ks * 32 + fq * 8);
#pragma unroll
            for (int m = 0; m < 4; ++m)
#pragma unroll
                for (int nt = 0; nt < 4; ++nt) acc[m][nt] = mfma16(b[nt], a[m], acc[m][nt]); }
        bf16_t* S = SST + ((size_t)(cgi * 16 + g * 4 + pair * 2 + hl) * 2 + dir) * 8192;
#pragma unroll
        for (int m = 0; m < 4; ++m)
#pragma unroll
            for (int nt = 0; nt < 4; ++nt) { u32x2 o; o.x = pk2(acc[m][nt][0], acc[m][nt][1]); o.y = pk2(acc[m][nt][2], acc[m][nt][3]);
                *(u32x2*)(S + (m * 16 + fr) * 128 + nhalf * 64 + nt * 16 + 4 * fq) = o; }
    }
    __syncthreads();
}

__device__ void ssd_y_unit(const Params& p, unsigned char* smem, int unit) {
    const int tid = opaque_tid(), wave = tid >> 6, lane = tid & 63, fr = lane & 15, fq = lane >> 4;
    const int cgi = unit >> 2, g = unit & 3, row0 = cgi * 128; int seq0, L; seq_of_row(row0, seq0, L);
    const int cidx = (row0 - seq0) >> 7, nc = L >> 7, cg0 = seq0 >> 7; const bool is_sample = row0 >= 4096; const int bs = (row0 - 4096) >> 10;
    const bf16_t* P = (const bf16_t*)(p.ws + OFF_P); const bf16_t* SST = (const bf16_t*)p.out; const float* DEC = (const float*)(p.ws + OFF_DEC); bf16_t* YC = (bf16_t*)(p.ws + OFF_YC);
    bf16_t* Cs = (bf16_t*)smem; bf16_t* BM = Cs + 128 * LDP; bf16_t* XT = BM + 128 * LDP; bf16_t* Hf = XT + 64 * LDP; bf16_t* Hb = Hf + 64 * LDP;
    float* vdt = (float*)(smem + 121856); float* vcum = (float*)(smem + 125952);
    dt_scan(p, vdt, vcum, row0, g);
#pragma unroll 1
    for (int which = 0; which < 2; ++which) { const int chl = (tid & 15) * 8, j0 = (tid >> 4) * 4; float o[4][8];
      conv_block4(p, P, seq0, L, row0, j0, (which ? 1024 : 1536) + g * 128 + chl, o);
      bf16_t* dst = which ? BM : Cs;
#pragma unroll
      for (int jj = 0; jj < 4; ++jj) { u32x4 a; a.x = pk2(o[jj][0], o[jj][1]); a.y = pk2(o[jj][2], o[jj][3]); a.z = pk2(o[jj][4], o[jj][5]); a.w = pk2(o[jj][6], o[jj][7]);
          *(u32x4*)(dst + (j0 + jj) * LDP + chl) = a; } }
    __syncthreads();
    const int i = wave * 16 + fr;
    f32x4 cb[8];
#pragma unroll
    for (int nt = 0; nt < 8; ++nt) cb[nt] = (f32x4){0.f, 0.f, 0.f, 0.f};
#pragma unroll
    for (int ks = 0; ks < 4; ++ks) { const bf16x8 a = *(const bf16x8*)(Cs + i * LDP + ks * 32 + fq * 8);
#pragma unroll
        for (int nt = 0; nt < 8; ++nt) { const bf16x8 b = *(const bf16x8*)(BM + (nt * 16 + fr) * LDP + ks * 32 + fq * 8); cb[nt] = mfma16(b, a, cb[nt]); } }
    __syncthreads();
    float ssq = 0.f;
    const int grow = row0 + i;
#pragma unroll 1
    for (int hh = 0; hh < 4; ++hh) {
        const int h = g * 4 + hh;
#pragma unroll 1
        for (int it = 0; it < 4; ++it) {
            const int v = tid + 512 * it, dir = v >> 10, e8 = (v & 1023) * 8;
            float ha[8];
#pragma unroll
            for (int e = 0; e < 8; ++e) ha[e] = 0.f;
            float coef = 1.f;
            if (dir == 0) { for (int c2 = cidx - 1; c2 >= 0; --c2) { const size_t sidx = (size_t)((cg0 + c2) * 16 + h) * 2; float x[8]; unpack8(*(const u32x4*)(SST + sidx * 8192 + e8), x);
#pragma unroll
                    for (int e = 0; e < 8; ++e) ha[e] = fmaf(coef, x[e], ha[e]);
                    coef *= DEC[sidx]; } }
            else { for (int c2 = cidx + 1; c2 < nc; ++c2) { const size_t sidx = (size_t)((cg0 + c2) * 16 + h) * 2 + 1; float x[8]; unpack8(*(const u32x4*)(SST + sidx * 8192 + e8), x);
#pragma unroll
                    for (int e = 0; e < 8; ++e) ha[e] = fmaf(coef, x[e], ha[e]);
                    coef *= DEC[sidx]; } }
            if (is_sample) { const float* h0 = p.in[dir ? 3 : 2] + (size_t)(bs * 16 + h) * 8192 + e8; const f32x4 a = *(const f32x4*)h0, c = *(const f32x4*)(h0 + 4);
                ha[0] = fmaf(coef, a[0], ha[0]); ha[1] = fmaf(coef, a[1], ha[1]); ha[2] = fmaf(coef, a[2], ha[2]); ha[3] = fmaf(coef, a[3], ha[3]);
                ha[4] = fmaf(coef, c[0], ha[4]); ha[5] = fmaf(coef, c[1], ha[5]); ha[6] = fmaf(coef, c[2], ha[6]); ha[7] = fmaf(coef, c[3], ha[7]); }
            u32x4 o; o.x = pk2(ha[0], ha[1]); o.y = pk2(ha[2], ha[3]); o.z = pk2(ha[4], ha[5]); o.w = pk2(ha[6], ha[7]);
            *(u32x4*)((dir ? Hb : Hf) + (e8 >> 7) * LDP + (e8 & 127)) = o;
        }
        if (tid < 256) { const int chl = (tid & 7) * 8, j0 = (tid >> 3) * 4; float o[4][8];
            conv_block4(p, P, seq0, L, row0, j0, g * 256 + hh * 64 + chl, o);
#pragma unroll
            for (int e = 0; e < 8; ++e) { u32x2 a; a.x = pk2(o[0][e], o[1][e]); a.y = pk2(o[2][e], o[3][e]); *(u32x2*)(XT + (chl + e) * LDP + j0) = a; } }
        const float pfi = vcum[(hh * 2) * 128 + i], sbi = vcum[(hh * 2 + 1) * 128 + i];
#pragma unroll
        for (int nt = 0; nt < 8; ++nt) { const int j0 = nt * 16 + 4 * fq;
            const f32x4 pfj = *(const f32x4*)(vcum + (hh * 2) * 128 + j0), sbj = *(const f32x4*)(vcum + (hh * 2 + 1) * 128 + j0);
            const f32x4 dfj = *(const f32x4*)(vdt + (hh * 2) * 128 + j0), dbj = *(const f32x4*)(vdt + (hh * 2 + 1) * 128 + j0);
            float mv[4];
#pragma unroll
            for (int r = 0; r < 4; ++r) { const int j = j0 + r; const float arg = j < i ? pfi - pfj[r] : sbi - sbj[r]; const float ex = __expf(fminf(arg, 0.f));
                const float m = j < i ? ex * dfj[r] : (j > i ? ex * dbj[r] : dfj[r] + dbj[r]); mv[r] = m * cb[nt][r]; }
            u32x2 o; o.x = pk2(mv[0], mv[1]); o.y = pk2(mv[2], mv[3]);
            *(u32x2*)(BM + i * LDP + j0) = o; }
        __syncthreads();
        f32x4 yd[4], tf[4], tb[4];
#pragma unroll
        for (int nt = 0; nt < 4; ++nt) { yd[nt] = (f32x4){0.f, 0.f, 0.f, 0.f}; tf[nt] = yd[nt]; tb[nt] = yd[nt]; }
#pragma unroll 1
        for (int ks = 0; ks < 4; ++ks) { const bf16x8 am = *(const bf16x8*)(BM + i * LDP + ks * 32 + fq * 8), ac = *(const bf16x8*)(Cs + i * LDP + ks * 32 + fq * 8);
#pragma unroll
            for (int nt = 0; nt < 4; ++nt) { const int ro = (nt * 16 + fr) * LDP + ks * 32 + fq * 8;
                yd[nt] = mfma16(*(const bf16x8*)(XT + ro), am, yd[nt]); tf[nt] = mfma16(*(const bf16x8*)(Hf + ro), ac, tf[nt]); tb[nt] = mfma16(*(const bf16x8*)(Hb + ro), ac, tb[nt]); } }
        const float ef = __expf(pfi), eb = __expf(sbi), ad = p.in[15][h];
#pragma unroll
        for (int nt = 0; nt < 4; ++nt) { const int p0 = nt * 16 + 4 * fq;
            const u32x2 zz = *(const u32x2*)(P + (size_t)grow * 6144 + h * 64 + p0);
            const float zf[4] = {bflo(zz.x), bfhi(zz.x), bflo(zz.y), bfhi(zz.y)}; float yv[4];
#pragma unroll
            for (int r = 0; r < 4; ++r) { const float x = bf2f(XT[(p0 + r) * LDP + i]);
                float y = yd[nt][r] + ef * tf[nt][r] + eb * tb[nt][r] + ad * x; y *= silu_f(zf[r]); ssq = fmaf(y, y, ssq); yv[r] = y; }
            u32x2 o; o.x = pk2(yv[0], yv[1]); o.y = pk2(yv[2], yv[3]); *(u32x2*)(YC + (size_t)grow * 2048 + h * 64 + p0) = o; }
        __syncthreads();
    }
    ssq += __shfl_xor(ssq, 16); ssq += __shfl_xor(ssq, 32);
    const float rs = rsqrtf(ssq * (1.f / 256.f) + 1e-5f);
#pragma unroll
    for (int hh = 0; hh < 4; ++hh)
#pragma unroll
        for (int nt = 0; nt < 4; ++nt) { const int ch = g * 256 + hh * 64 + nt * 16 + 4 * fq; const f32x4 nw = *(const f32x4*)(p.in[16] + ch);
            const u32x2 yy = *(const u32x2*)(YC + (size_t)grow * 2048 + ch);
            u32x2 o; o.x = pk2(bflo(yy.x) * rs * nw[0], bfhi(yy.x) * rs * nw[1]); o.y = pk2(bflo(yy.y) * rs * nw[2], bfhi(yy.y) * rs * nw[3]);
            *(u32x2*)(YC + (size_t)grow * 2048 + ch) = o; }
    if (!is_sample && cidx == 0) {
        const int bp = seq0 >> 8;
#pragma unroll 1
        for (int q = tid; q < 8 * 1024; q += 512) {
            const int hd = q >> 10, hh = hd >> 1, dir = hd & 1, e8 = (q & 1023) * 8, h = g * 4 + hh;
            const size_t s0 = (size_t)((cg0) * 16 + h) * 2 + dir, s1 = (size_t)((cg0 + 1) * 16 + h) * 2 + dir;
            float x0[8], x1[8]; unpack8(*(const u32x4*)(SST + s0 * 8192 + e8), x0); unpack8(*(const u32x4*)(SST + s1 * 8192 + e8), x1);
            f32x4 a, c;
            if (dir == 0) { const float d = DEC[s1]; a = (f32x4){x0[0] * d + x1[0], x0[1] * d + x1[1], x0[2] * d + x1[2], x0[3] * d + x1[3]}; c = (f32x4){x0[4] * d + x1[4], x0[5] * d + x1[5], x0[6] * d + x1[6], x0[7] * d + x1[7]}; }
            else { const float d = DEC[s0]; a = (f32x4){x1[0] * d + x0[0], x1[1] * d + x0[1], x1[2] * d + x0[2], x1[3] * d + x0[3]}; c = (f32x4){x1[4] * d + x0[4], x1[5] * d + x0[5], x1[6] * d + x0[6], x1[7] * d + x0[7]}; }
            float* o = p.out + (dir ? OUT_STB : OUT_STF) + (size_t)(bp * 16 + h) * 8192 + e8;
            *(f32x4*)o = a; *(f32x4*)(o + 4) = c;
        }
    }
    __syncthreads();
}

__device__ void gmlp_unit(const Params& p, unsigned char* smem, int unit) {
    const int tid = opaque_tid(), wave = tid >> 6, lane = tid & 63, fr = lane & 15, fq = lane >> 4;
    const int cgi = unit >> 4, g = unit & 15, row0 = cgi * 128;
    const bf16_t* P = (const bf16_t*)(p.ws + OFF_P); bf16_t* YC = (bf16_t*)(p.ws + OFF_YC); const float* LNP = (const float*)(p.ws + OFF_DT);
    bf16_t* Ws = (bf16_t*)smem; bf16_t* VT = Ws + 128 * LDP; float* stat = (float*)(smem + 69632);
    { const int j = tid >> 2, q = tid & 3; float s1 = 0.f, s2 = 0.f; const float* lp = LNP + ((size_t)(row0 + j) * 32 + q * 8) * 2;
#pragma unroll
      for (int k = 0; k < 8; ++k) { s1 += lp[2 * k]; s2 += lp[2 * k + 1]; }
      s1 += __shfl_xor(s1, 1); s2 += __shfl_xor(s2, 1); s1 += __shfl_xor(s1, 2); s2 += __shfl_xor(s2, 2);
      const float mean = s1 * (1.f / 2048.f), var = fmaxf(s2 * (1.f / 2048.f) - mean * mean, 0.f);
      if (q == 0) { stat[j * 2] = mean; stat[j * 2 + 1] = rsqrtf(var + 1e-5f); } }
    { const float* wsrc = p.in[29] + (size_t)g * 16384;
#pragma unroll
      for (int it = 0; it < 4; ++it) { const int bb = tid + 512 * it, row = bb >> 4, c8 = (bb & 15) * 8; const f32x4 a = *(const f32x4*)(wsrc + row * 128 + c8), c = *(const f32x4*)(wsrc + row * 128 + c8 + 4);
          u32x4 o; o.x = pk2(a[0], a[1]); o.y = pk2(a[2], a[3]); o.z = pk2(c[0], c[1]); o.w = pk2(c[2], c[3]); *(u32x4*)(Ws + row * LDP + c8) = o; } }
    __syncthreads();
    { const int d0 = (tid & 15) * 8, j0 = (tid >> 4) * 4; const int ch = g * 128 + d0;
      const f32x4 ga = *(const f32x4*)(p.in[27] + ch), gb = *(const f32x4*)(p.in[27] + ch + 4), ba = *(const f32x4*)(p.in[28] + ch), bb = *(const f32x4*)(p.in[28] + ch + 4);
      const float gg[8] = {ga[0], ga[1], ga[2], ga[3], gb[0], gb[1], gb[2], gb[3]}, be[8] = {ba[0], ba[1], ba[2], ba[3], bb[0], bb[1], bb[2], bb[3]};
      float vn[4][8];
#pragma unroll
      for (int jj = 0; jj < 4; ++jj) { float x[8]; unpack8(*(const u32x4*)(P + (size_t)(row0 + j0 + jj) * 6144 + 2048 + ch), x); const float mean = stat[(j0 + jj) * 2], rstd = stat[(j0 + jj) * 2 + 1];
#pragma unroll
          for (int e = 0; e < 8; ++e) vn[jj][e] = (x[e] - mean) * rstd * gg[e] + be[e]; }
#pragma unroll
      for (int e = 0; e < 8; ++e) { u32x2 o; o.x = pk2(vn[0][e], vn[1][e]); o.y = pk2(vn[2][e], vn[3][e]); *(u32x2*)(VT + (d0 + e) * LDP + j0) = o; } }
    __syncthreads();
    const int i = wave * 16 + fr;
    f32x4 acc[8];
#pragma unroll
    for (int nt = 0; nt < 8; ++nt) acc[nt] = (f32x4){0.f, 0.f, 0.f, 0.f};
#pragma unroll
    for (int ks = 0; ks < 4; ++ks) { const bf16x8 a = *(const bf16x8*)(Ws + i * LDP + ks * 32 + fq * 8);
#pragma unroll
        for (int nt = 0; nt < 8; ++nt) acc[nt] = mfma16(*(const bf16x8*)(VT + (nt * 16 + fr) * LDP + ks * 32 + fq * 8), a, acc[nt]); }
    const float bsi = p.in[30][g * 128 + i];
    const size_t grow = (size_t)(row0 + i);
#pragma unroll
    for (int nt = 0; nt < 8; ++nt) { const int ch = g * 128 + nt * 16 + 4 * fq;
        const u32x2 uu = *(const u32x2*)(P + grow * 6144 + ch), gt = *(const u32x2*)(P + grow * 6144 + 4096 + ch);
        const float o0 = bflo(uu.x) * (acc[nt][0] + bsi) * silu_f(bflo(gt.x)), o1 = bfhi(uu.x) * (acc[nt][1] + bsi) * silu_f(bfhi(gt.x));
        const float o2 = bflo(uu.y) * (acc[nt][2] + bsi) * silu_f(bflo(gt.y)), o3 = bfhi(uu.y) * (acc[nt][3] + bsi) * silu_f(bfhi(gt.y));
        u32x2 o; o.x = pk2(o0, o1); o.y = pk2(o2, o3); *(u32x2*)(YC + grow * 2048 + ch) = o; }
    __syncthreads();
}

__device__ void ln_phase(const Params& p, int layer) {
    const int tid = opaque_tid(), wave = tid >> 6, lane = tid & 63;
    const float* G = p.in[layer ? 32 : 22]; const float* B = p.in[layer ? 33 : 23];
    const float* MODS = (const float*)(p.ws + OFF_MODS) + 9 * 3072; bf16_t* H = (bf16_t*)(p.ws + OFF_H);
    for (int r = blockIdx.x * 8 + wave; r < NTOK; r += gridDim.x * 8) {
        float* xr = p.out + (size_t)r * 1024; f32x4 v[4]; float s = 0.f;
#pragma unroll
        for (int i = 0; i < 4; ++i) { v[i] = *(const f32x4*)(xr + lane * 4 + 256 * i); s += v[i][0] + v[i][1] + v[i][2] + v[i][3]; }
#pragma unroll
        for (int o = 1; o < 64; o <<= 1) s += __shfl_xor(s, o);
        const float mean = s * (1.f / 1024.f); float q = 0.f;
#pragma unroll
        for (int i = 0; i < 4; ++i) { v[i] -= mean; q += v[i][0] * v[i][0] + v[i][1] * v[i][1] + v[i][2] * v[i][2] + v[i][3] * v[i][3]; }
#pragma unroll
        for (int o = 1; o < 64; o <<= 1) q += __shfl_xor(q, o);
        const float rstd = rsqrtf(q * (1.f / 1024.f) + 1e-5f);
        const int cond = cond_of_row(r);
#pragma unroll
        for (int i = 0; i < 4; ++i) { const int c = lane * 4 + 256 * i; const f32x4 y = v[i] * rstd * *(const f32x4*)(G + c) + *(const f32x4*)(B + c);
            *(f32x4*)(xr + c) = y;
            if (layer == 0) { const f32x4 sh = *(const f32x4*)(MODS + cond * 3072 + c), sc = *(const f32x4*)(MODS + cond * 3072 + 1024 + c); const f32x4 h = y * (sc + 1.0f) + sh;
                u32x2 o; o.x = pk2(h[0], h[1]); o.y = pk2(h[2], h[3]); *(u32x2*)(H + (size_t)r * 1024 + c) = o; } }
    }
}

constexpr int NPHASE = 11;
template <int PH> __device__ __forceinline__ void run_phase(const Params& p, unsigned char* shm) {
    const bf16_t* H = (const bf16_t*)(p.ws + OFF_H); bf16_t* Pb = (bf16_t*)(p.ws + OFF_P); const bf16_t* YC = (const bf16_t*)(p.ws + OFF_YC);
    const float* MODS = (const float*)(p.ws + OFF_MODS);
    if constexpr (PH == 0) phase_prep(p, shm);
    if constexpr (PH == 1) phase_conv_h0(p, shm);
    if constexpr (PH == 2 || PH == 7) {
        pg8::Gemm g; g.A = H; g.Bt = (const bf16_t*)(p.ws + (PH == 2 ? OFF_WT0 : OFF_WT1)); g.M = NTOK; g.N = PH == 2 ? 6400 : 6144; g.K = 1024;
        pg8::StaticOrder S; S.init(g.M, g.N, (int)gridDim.x, (int)blockIdx.x);
        EpiIn E; E.P = Pb; E.DT = (float*)(p.ws + OFF_DT); E.LNP = PH == 2 ? nullptr : (float*)(p.ws + OFF_DT);
        pg8::gemm_phase<EpiIn, pg8::StaticOrder, false>((PG8_LAS unsigned char*)shm, g, S, E, nullptr);
    }
    if constexpr (PH == 3) { for (int u = blockIdx.x; u < 384; u += gridDim.x) sstate_unit(p, shm, u);
        for (int u = gridDim.x - 1 - blockIdx.x; u < 768; u += gridDim.x) conformer_unit(p, shm, u); }
    if constexpr (PH == 4) { for (int u = blockIdx.x; u < 384; u += gridDim.x) ssd_y_unit(p, shm, u); }
    if constexpr (PH == 5 || PH == 9) {
        pg8::Gemm g; g.A = YC; g.Bt = (const bf16_t*)(p.ws + (PH == 5 ? OFF_WO0 : OFF_WO1)); g.M = NTOK; g.N = 1024; g.K = 2048;
        pg8::StaticOrder S; S.init(g.M, g.N, (int)gridDim.x, (int)blockIdx.x);
        EpiOut E; E.R = p.out; E.xp = p.in[0]; E.xs = p.in[1]; E.posr = (const float*)(p.ws + OFF_POSR); E.posc = (const float*)(p.ws + OFF_POSC);
        E.gate = MODS + (PH == 5 ? 0 : 9 * 3072) + 2048; E.layer = PH == 5 ? 0 : 1;
        pg8::gemm_phase<EpiOut, pg8::StaticOrder, false>((PG8_LAS unsigned char*)shm, g, S, E, nullptr);
    }
    if constexpr (PH == 6) ln_phase(p, 0);
    if constexpr (PH == 8) { for (int u = blockIdx.x; u < 1536; u += gridDim.x) gmlp_unit(p, shm, u); }
    if constexpr (PH == 10) ln_phase(p, 1);
}

#ifndef MULTI_LAUNCH
__global__ __launch_bounds__(512, 2) void mega_kernel(Params p) {
    extern __shared__ __attribute__((aligned(16))) unsigned char shm[];
    cg::grid_group grid = cg::this_grid();
    run_phase<0>(p, shm); grid.sync();
    run_phase<1>(p, shm); grid.sync();
    run_phase<2>(p, shm); grid.sync();
    run_phase<3>(p, shm); grid.sync();
    run_phase<4>(p, shm); grid.sync();
    run_phase<5>(p, shm); grid.sync();
    run_phase<6>(p, shm); grid.sync();
    run_phase<7>(p, shm); grid.sync();
    run_phase<8>(p, shm); grid.sync();
    run_phase<9>(p, shm); grid.sync();
    run_phase<10>(p, shm);
}
#else
template <int PH> __global__ __launch_bounds__(512, 2) void phase_kernel(Params p) {
    extern __shared__ __attribute__((aligned(16))) unsigned char shm[];
    run_phase<PH>(p, shm);
}
template <int PH> static void launch_phase(const Params& p, hipStream_t stream) {
    hipFuncSetAttribute((const void*)phase_kernel<PH>, hipFuncAttributeMaxDynamicSharedMemorySize, 131072);
    phase_kernel<PH><<<256, 512, 131072, stream>>>(p);
}
#endif

extern "C" void kernel_launch(void* const* d_in, const int* in_sizes, int n_in, void* d_out, int out_size, void* d_ws, size_t ws_size, hipStream_t stream) {
    Params p{};
    for (int i = 0; i < 34; ++i) p.in[i] = (const float*)d_in[i];
    p.out = (float*)d_out; p.ws = (unsigned char*)d_ws;
    constexpr size_t kDynLds = 131072;
#ifndef MULTI_LAUNCH
    static int grid_blocks = 0;
    if (!grid_blocks) {
        int dev = 0, cus = 0, per_cu = 0;
        hipGetDevice(&dev);
        hipDeviceGetAttribute(&cus, hipDeviceAttributeMultiprocessorCount, dev);
        hipFuncSetAttribute((const void*)mega_kernel, hipFuncAttributeMaxDynamicSharedMemorySize, (int)kDynLds);
        hipOccupancyMaxActiveBlocksPerMultiprocessor(&per_cu, mega_kernel, 512, kDynLds);
        if (per_cu < 1) per_cu = 1;
        grid_blocks = cus * (per_cu > 1 ? 1 : per_cu);
    }
    void* args[] = {&p};
    hipError_t e = hipLaunchCooperativeKernel((void*)mega_kernel, dim3(grid_blocks), dim3(512), args, kDynLds, stream);
    if (e != hipSuccess) fprintf(stderr, "cooperative launch failed: %s (grid %d)\n", hipGetErrorString(e), grid_blocks);
#else
    launch_phase<0>(p, stream); launch_phase<1>(p, stream); launch_phase<2>(p, stream); launch_phase<3>(p, stream); launch_phase<4>(p, stream); launch_phase<5>(p, stream);
    launch_phase<6>(p, stream); launch_phase<7>(p, stream); launch_phase<8>(p, stream); launch_phase<9>(p, stream); launch_phase<10>(p, stream);
#endif
}
```

```cpp
#include <hip/hip_runtime.h>
#include <hip/hip_cooperative_groups.h>
#include <cstdio>
namespace cg = cooperative_groups;
namespace pg8 {
#define PG8_LAS __attribute__((address_space(3)))
typedef unsigned short bf16_t;
typedef short bf16x8 __attribute__((ext_vector_type(8)));
typedef float f32x4 __attribute__((ext_vector_type(4)));
typedef unsigned u32x4 __attribute__((ext_vector_type(4)));
constexpr int BM = 256, BK = 64, HALF = 128, HTB = HALF * BK * 2  , STAGE_BYTES = 8 * HTB, NXCD = 8, WGM = 8;

__host__ __device__ __forceinline__ int lds_byte(int r, int c) { const int st = (r >> 4) * 2 + (c >> 5), rr = r & 15, cc = c & 31, ob = rr * 64 + cc * 2; return st * 1024 + (ob ^ (((ob >> 9) & 1) << 5)); }
__host__ __device__ __forceinline__ void stage_rc(int b, int& R, int& C) { const int st = b / 1024, sb = b % 1024, swz = sb ^ (((sb >> 9) & 1) << 5); R = (st >> 1) * 16 + swz / 64; C = (st & 1) * 32 + (swz % 64) / 2; }
__host__ __device__ __forceinline__ int perm32(int rho) { const int n = rho >> 4, i = rho & 15; return 8 * (i >> 2) + 4 * n + (i & 3); }

struct Unit { int pm, pn; };
struct Gemm { const bf16_t* A; const bf16_t* Bt; int M, N, K; };

struct StaticOrder {
    int nM, nN, nwg, G, c;
    __host__ __device__ void init(int M, int N, int G_, int c_) { nM = M / BM; nN = N / BM; nwg = nM * nN; G = G_; c = c_; }
    __host__ __device__ bool next(int i, Unit& u) const {
        const long L = (long)i * G + c; if (L >= nwg) return false;
        int wgid = (int)L; { const int q = nwg / NXCD, r = nwg % NXCD, xcd = wgid % NXCD, off = wgid / NXCD; wgid = (xcd < r ? xcd * (q + 1) : r * (q + 1) + (xcd - r) * q) + off; }
        const int nig = WGM * nN, gid = wgid / nig, fm = gid * WGM, gsz = (nM - fm) < WGM ? (nM - fm) : WGM;
        u.pm = fm + ((wgid % nig) % gsz); u.pn = (wgid % nig) / gsz; return true;
    }
    __device__ __forceinline__ void a_ready(const Unit&) const {}
    __device__ __forceinline__ void done(const Unit&) const {}
};
typedef __bf16 bf16x2n_t __attribute__((ext_vector_type(2))); typedef float f32x2n_t __attribute__((ext_vector_type(2)));
__device__ __forceinline__ unsigned cvt_pk_bf16(float lo, float hi) { f32x2n_t v = {lo, hi}; bf16x2n_t r = __builtin_convertvector(v, bf16x2n_t); return __builtin_bit_cast(unsigned, r); }
template <class Epi, class Sched, bool STAMP = false>
__device__ __forceinline__ void gemm_phase(PG8_LAS unsigned char* lds, const Gemm g, const Sched& S, const Epi& E, unsigned long long* stamps) {
    int tid_ = threadIdx.x; asm volatile("" : "+v"(tid_));
    const int tid = tid_, wid = __builtin_amdgcn_readfirstlane(tid >> 6), lane = tid & 63, wr = wid >> 2, wc = wid & 3, fr = lane & 15, fq = lane >> 4;
    const int K = g.K, nt = K / BK;
    int ts_lo = 0, ts_hi = 0, nts = 0; const unsigned long long rt_entry = STAMP ? (unsigned long long)wall_clock64() : 0ull;
#define PG8_STAMP() do { if (STAMP && wid == 0 && nts < 64) { const unsigned long long _c = (unsigned long long)clock64(); \
        ts_lo = (lane == nts) ? (int)(unsigned)_c : ts_lo; ts_hi = (lane == nts) ? (int)(unsigned)(_c >> 32) : ts_hi; ++nts; } } while (0)
    PG8_STAMP();
    unsigned voffA[2], voffB[2];
#pragma unroll
    for (int i = 0; i < 2; ++i) { int R, C; stage_rc(tid * 16 + i * 8192, R, C); const int Rb = Epi::PERM ? ((R & ~31) + perm32(R & 31)) : R;
        voffA[i] = (unsigned)(R * K + C) * 2u; voffB[i] = (unsigned)(Rb * K + C) * 2u; }
    const size_t kstep = (size_t)(BK * 2);
    const size_t hstep = (size_t)HALF * K * 2;
    const size_t tstep = 2 * hstep;
    const unsigned ldsw = (unsigned)wid * 1024u;
    const int aoff = lds_byte(wr * 64 + fr, fq * 8), boff = lds_byte(wc * 32 + fr, fq * 8);
#define PG8_SA(b, h) (((b) * 2 + (h)) * HTB)
#define PG8_SB(b, h) ((4 + (b) * 2 + (h)) * HTB)
#define PG8_STAGE(bufoff, gbase, voff) do { _Pragma("unroll") for (int _i = 0; _i < 2; ++_i) \
        __builtin_amdgcn_global_load_lds((const unsigned*)((const char*)(gbase) + (voff)[_i]), (PG8_LAS unsigned*)(lds + (bufoff) + ldsw + _i * 8192), 16, 0, 0); } while (0)
#define PG8_LDA(dst, b, h) do { _Pragma("unroll") for (int m = 0; m < 4; ++m) _Pragma("unroll") for (int k = 0; k < 2; ++k) dst[m][k] = *(const PG8_LAS bf16x8*)(lds + PG8_SA(b, h) + aoff + m * 2048 + k * 1024); } while (0)
#define PG8_LDB(dst, b, h) do { _Pragma("unroll") for (int n = 0; n < 2; ++n) _Pragma("unroll") for (int k = 0; k < 2; ++k) dst[n][k] = *(const PG8_LAS bf16x8*)(lds + PG8_SB(b, h) + boff + n * 2048 + k * 1024); } while (0)
#define PG8_MMA(ai, bj, At, Bt) do { __builtin_amdgcn_s_setprio(1); _Pragma("unroll") for (int m = 0; m < 4; ++m) _Pragma("unroll") for (int n = 0; n < 2; ++n) _Pragma("unroll") for (int k = 0; k < 2; ++k) \
        acc[ai][bj][m][n] = __builtin_amdgcn_mfma_f32_16x16x32_bf16(Bt[n][k], At[m][k], acc[ai][bj][m][n], 0, 0, 0); __builtin_amdgcn_s_setprio(0); } while (0)
#define PG8_WAIT_V(n) asm volatile("s_waitcnt vmcnt(" #n ")" ::: "memory")
#define PG8_WAIT_L(n) asm volatile("s_waitcnt lgkmcnt(" #n ")" ::: "memory")
#define PG8_BAR __builtin_amdgcn_s_barrier()
#define PG8_SCHED __builtin_amdgcn_sched_barrier(0)
    Unit cur, nxt; int ui = 0;
    if (!S.next(0, cur)) return;
    f32x4 acc[2][2][4][2];
#pragma unroll
    for (int a = 0; a < 2; ++a)
#pragma unroll
        for (int b = 0; b < 2; ++b)
#pragma unroll
            for (int m = 0; m < 4; ++m)
#pragma unroll
                for (int n = 0; n < 2; ++n) acc[a][b][m][n] = (f32x4){0.f, 0.f, 0.f, 0.f};
    bf16x8 At[4][2], B0[2][2], B1[2][2];
    const char* cA = (const char*)g.A + (size_t)cur.pm * tstep; const char* cB = (const char*)g.Bt + (size_t)cur.pn * tstep;
    S.a_ready(cur);
    PG8_STAGE(PG8_SB(0, 0), cB, voffB); PG8_STAGE(PG8_SA(0, 0), cA, voffA); PG8_STAGE(PG8_SB(0, 1), cB + hstep, voffB); PG8_STAGE(PG8_SA(0, 1), cA + hstep, voffA);
    if (wr == 1) PG8_BAR;
    PG8_WAIT_V(4); PG8_BAR;
    PG8_STAGE(PG8_SB(1, 0), cB + kstep, voffB); PG8_STAGE(PG8_SA(1, 0), cA + kstep, voffA); PG8_STAGE(PG8_SB(1, 1), cB + hstep + kstep, voffB);
    PG8_WAIT_V(6); PG8_BAR;
    PG8_STAMP();
    for (;;) {
        const bool has_next = S.next(ui + 1, nxt);
        const char* nA = has_next ? (const char*)g.A + (size_t)nxt.pm * tstep : cA; const char* nB = has_next ? (const char*)g.Bt + (size_t)nxt.pn * tstep : cB;
        for (int t = 0; t < nt; t += 2) {
            const bool last = (t == nt - 2);
            const char* a1 = cA + (size_t)(t + 1) * kstep;
            const char* a2 = last ? nA : cA + (size_t)(t + 2) * kstep; const char* b2 = last ? nB : cB + (size_t)(t + 2) * kstep;
            const char* a3 = a2 + kstep; const char* b3 = b2 + kstep;
            if (last && has_next) S.a_ready(nxt);
            PG8_LDB(B0, 0, 0); PG8_SCHED; PG8_LDA(At, 0, 0); PG8_STAGE(PG8_SA(1, 1), a1 + hstep, voffA);
            PG8_WAIT_L(8); PG8_BAR; PG8_WAIT_L(0); PG8_MMA(0, 0, At, B0); PG8_BAR; PG8_SCHED;
            PG8_LDB(B1, 0, 1); PG8_STAGE(PG8_SB(0, 0), b2, voffB);
            PG8_BAR; PG8_WAIT_L(0); PG8_MMA(0, 1, At, B1); PG8_BAR;
            PG8_LDA(At, 0, 1); PG8_STAGE(PG8_SA(0, 0), a2, voffA);
            PG8_BAR; PG8_WAIT_L(0); PG8_MMA(1, 0, At, B0); PG8_BAR; PG8_SCHED;
            PG8_STAGE(PG8_SB(0, 1), b2 + hstep, voffB);
            PG8_WAIT_V(6); PG8_BAR; PG8_MMA(1, 1, At, B1); PG8_BAR;
            PG8_LDB(B0, 1, 0); PG8_SCHED; PG8_LDA(At, 1, 0); PG8_STAGE(PG8_SA(0, 1), a2 + hstep, voffA);
            PG8_WAIT_L(8); PG8_BAR; PG8_WAIT_L(0); PG8_MMA(0, 0, At, B0); PG8_BAR; PG8_SCHED;
            PG8_LDB(B1, 1, 1); PG8_STAGE(PG8_SB(1, 0), b3, voffB);
            PG8_BAR; PG8_WAIT_L(0); PG8_MMA(0, 1, At, B1); PG8_BAR;
            PG8_LDA(At, 1, 1); PG8_STAGE(PG8_SA(1, 0), a3, voffA);
            PG8_BAR; PG8_WAIT_L(0); PG8_MMA(1, 0, At, B0); PG8_BAR; PG8_SCHED;
            PG8_STAGE(PG8_SB(1, 1), b3 + hstep, voffB);
            PG8_WAIT_V(6); PG8_BAR; PG8_MMA(1, 1, At, B1); PG8_BAR;
        }
        PG8_STAMP();
        if constexpr (!Epi::AFTER_DRAIN) { E(acc, cur, wr, wc, fr, fq); S.done(cur); }
        PG8_STAMP();
        if (!has_next) break;
#pragma unroll
        for (int a = 0; a < 2; ++a)
#pragma unroll
            for (int b = 0; b < 2; ++b)
#pragma unroll
                for (int m = 0; m < 4; ++m)
#pragma unroll
                    for (int n = 0; n < 2; ++n) acc[a][b][m][n] = (f32x4){0.f, 0.f, 0.f, 0.f};
        cur = nxt; cA = nA; cB = nB; ++ui;
    }
    PG8_WAIT_V(0);
    if (wr == 0) PG8_BAR;
    PG8_BAR;
    if constexpr (Epi::AFTER_DRAIN) { E.fused(acc, cur, wr, wc, fr, fq, lds, wid, lane); S.done(cur); }
    PG8_STAMP();
    if (STAMP && wid == 0) { stamps[lane] = lane < nts ? (((unsigned long long)(unsigned)ts_hi << 32) | (unsigned)ts_lo) : 0ull;
        if (lane == 62) stamps[62] = rt_entry; if (lane == 63) stamps[63] = (unsigned long long)wall_clock64(); }
#undef PG8_STAMP
#undef PG8_SA
#undef PG8_SB
#undef PG8_STAGE
#undef PG8_LDA
#undef PG8_LDB
#undef PG8_MMA
#undef PG8_WAIT_V
#undef PG8_WAIT_L
#undef PG8_BAR
#undef PG8_SCHED
}
}
#define XB_TMO      128
#define XB_XCNT(j)  (256  + 64 * (j))
#define XB_XSUB(j)  (1280 + 64 * (j))
#define XB_XGEN(j)  (2304 + 64 * (j))
#define XB_TOP      3328
#define XB_TOPGEN   3392
#define XCD_BAR_WORDS 3456
#define XB_SPIN_CAP (1u << 18)
#define LAS __attribute__((address_space(3)))

__device__ __forceinline__ unsigned xb_ld(unsigned* p)              { return __hip_atomic_load(p, __ATOMIC_RELAXED, __HIP_MEMORY_SCOPE_AGENT); }
__device__ __forceinline__ unsigned xb_add(unsigned* p, unsigned v) { return __hip_atomic_fetch_add(p, v, __ATOMIC_RELAXED, __HIP_MEMORY_SCOPE_AGENT); }
__device__ __forceinline__ unsigned xb_xcc_id() { return (unsigned)__builtin_amdgcn_s_getreg((3 << 11) | 20) & 0xFu; }
#define XB_SPIN(cond, bar) do { unsigned _sp = 0; while (cond) { __builtin_amdgcn_s_sleep(1); \
    if ((++_sp & 255u) == 0u) { if (xb_ld(&(bar)[XB_TMO])) break; if (_sp > XB_SPIN_CAP) { atomicAdd(&(bar)[XB_TMO], 1u); break; } } } } while (0)

struct XcdBarrier {
    unsigned* bar; unsigned x;
    volatile LAS unsigned* st;
};

__device__ __forceinline__ XcdBarrier xcd_barrier_post(unsigned* bar, volatile LAS unsigned* st) {
    XcdBarrier b; b.bar = bar; b.x = xb_xcc_id(); b.st = st;
    if (threadIdx.x == 0) (void)xb_add(&bar[XB_XCNT(b.x)], 1u);
    return b;
}
__device__ __forceinline__ void xcd_barrier_complete(unsigned* bar, unsigned x, unsigned& nloc, unsigned& nx) {
    const unsigned G = gridDim.x * gridDim.y * gridDim.z;
    unsigned sum, cnt, mine, sp = 0u;
    for (;;) {
        sum = 0u; cnt = 0u; mine = 0u;
#pragma unroll
        for (unsigned j = 0; j < 16; ++j) { const unsigned c = xb_ld(&bar[XB_XCNT(j)]); sum += c; cnt += (c > 0u) ? 1u : 0u; mine = (j == x) ? c : mine; }
        if (sum == G) break;
        __builtin_amdgcn_s_sleep(1);
        if ((++sp & 255u) == 0u) { if (xb_ld(&bar[XB_TMO])) break; if (sp > XB_SPIN_CAP) { atomicAdd(&bar[XB_TMO], 1u); break; } }
    }
    nloc = mine > 0u ? mine : 1u; nx = cnt > 0u ? cnt : 1u;
}

__device__ __forceinline__ void xcd_barrier(const XcdBarrier& b) {
    asm volatile("s_waitcnt vmcnt(0)" ::: "memory");
    __syncthreads();
    if (threadIdx.x == 0) {
        unsigned* bar = b.bar;
        __builtin_amdgcn_s_waitcnt(0);
        unsigned nloc = b.st[0], nx = b.st[1];
        if (nloc == 0u) { xcd_barrier_complete(bar, b.x, nloc, nx); b.st[0] = nloc; b.st[1] = nx; }
        const unsigned old = xb_add(&bar[XB_XSUB(b.x)], 1u);
        const unsigned gen = old / nloc;
        if (old + 1u == (gen + 1u) * nloc) {
            __builtin_amdgcn_fence(__ATOMIC_RELEASE, "agent");
            asm volatile("s_waitcnt vmcnt(0)" ::: "memory");
            const unsigned og = xb_add(&bar[XB_TOP], 1u);
            const unsigned tg = og / nx;
            if (og + 1u == (tg + 1u) * nx) xb_add(&bar[XB_TOPGEN], 1u);
            else XB_SPIN(xb_ld(&bar[XB_TOPGEN]) == tg, bar);
            __builtin_amdgcn_fence(__ATOMIC_ACQUIRE, "agent");
            xb_add(&bar[XB_XGEN(b.x)], 1u);
            asm volatile("s_waitcnt vmcnt(0)" ::: "memory");
        } else {
            XB_SPIN(xb_ld(&bar[XB_XGEN(b.x)]) == gen, bar);
            __builtin_amdgcn_fence(__ATOMIC_ACQUIRE, "agent");
            asm volatile("s_waitcnt vmcnt(0)" ::: "memory");
        }
    }
    __syncthreads();
}


using pg8::bf16x8; using pg8::f32x4; using pg8::u32x4;
typedef unsigned short bf16_t;
typedef unsigned u32x2 __attribute__((ext_vector_type(2)));
typedef float f32x2v __attribute__((ext_vector_type(2)));

struct Params { const float* in[34]; float* out; unsigned char* ws; };

constexpr int NTOK = 12288;
constexpr size_t OFF_WT0 = 0, OFF_WO0 = 13107200, OFF_WT1 = 17301504, OFF_WO1 = 29884416, OFF_H = 34078720, OFF_P = 59244544,
                 OFF_YC = 210239488, OFF_DT = 260571136, OFF_MODS = 263716864, OFF_POSR = 263938048, OFF_POSC = 263970816, OFF_DEC = 264101888, OFF_BAR = 264114176;
constexpr size_t OUT_STF = 12582912, OUT_STB = 14680064;
constexpr float ALPHA_C = 1.41421356237f;
constexpr int LDP = 136;

__device__ __forceinline__ float bf2f(unsigned short b) { return __uint_as_float(((unsigned)b) << 16); }
__device__ __forceinline__ float bflo(unsigned u) { return __uint_as_float(u << 16); }
__device__ __forceinline__ float bfhi(unsigned u) { return __uint_as_float(u & 0xffff0000u); }
__device__ __forceinline__ unsigned pk2(float lo, float hi) { return pg8::cvt_pk_bf16(lo, hi); }
__device__ __forceinline__ float silu_f(float x) { return x * __builtin_amdgcn_rcpf(1.f + __expf(-x)); }
__device__ __forceinline__ float sigmoid_f(float x) { return __builtin_amdgcn_rcpf(1.f + __expf(-x)); }
__device__ __forceinline__ int swz(int r, int j) { return r * LDP + ((((j >> 3) ^ (r >> 3)) & 15) << 3) + (j & 7); }
__device__ __forceinline__ float softplus_f(float x) { return x > 20.f ? x : log1pf(expf(x)); }
__device__ __forceinline__ f32x4 mfma16(bf16x8 a, bf16x8 b, f32x4 c) { return __builtin_amdgcn_mfma_f32_16x16x32_bf16(a, b, c, 0, 0, 0); }
__device__ __forceinline__ void unpack8(u32x4 v, float (&o)[8]) { o[0] = bflo(v.x); o[1] = bfhi(v.x); o[2] = bflo(v.y); o[3] = bfhi(v.y); o[4] = bflo(v.z); o[5] = bfhi(v.z); o[6] = bflo(v.w); o[7] = bfhi(v.w); }
__device__ __forceinline__ int opaque_tid() { int t = threadIdx.x; asm volatile("" : "+v"(t)); return t; }
__device__ __forceinline__ int cond_of_row(int r) { return r < 4096 ? 0 : 1 + ((r - 4096) >> 10); }

template <int WHICH> __device__ __forceinline__ void tr_load(const float* __restrict__ src, int tt, int tid, f32x4 (&v)[4]) {
    constexpr int K = (WHICH == 0 || WHICH == 2) ? 1024 : 2048, Nsrc = WHICH == 0 ? 6176 : (WHICH == 2 ? 6144 : 1024), nkt = K / 64;
    const int ntile = tt / nkt, ktile = tt % nkt;
#pragma unroll
    for (int i = 0; i < 4; ++i) { const int idx = tid + 512 * i, k = idx >> 5, nd = ntile * 128 + (idx & 31) * 4; int ns = nd; bool ok = true;
        if (WHICH == 0) { if (nd < 3072) ns = nd; else if (nd < 5120) { const int t = (nd - 3072) >> 8, lc = (nd - 3072) & 255; ns = lc < 128 ? 3104 + 128 * t + lc : 4128 + 128 * t + (lc - 128); } else if (nd < 6144) ns = nd + 32; else if (nd < 6176) ns = nd - 3072; else { ok = false; ns = 0; } }
        const f32x4 x = *(const f32x4*)(src + (size_t)(ktile * 64 + k) * Nsrc + ns); v[i] = ok ? x : (f32x4){0.f, 0.f, 0.f, 0.f}; }
}
template <int WHICH> __device__ __forceinline__ void transpose_tiles(const float* __restrict__ src, bf16_t* __restrict__ dst, float* tile, int bidx, int nb) {
    constexpr int K = (WHICH == 0 || WHICH == 2) ? 1024 : 2048, Nsrc = WHICH == 0 ? 6176 : (WHICH == 2 ? 6144 : 1024), Ndst = WHICH == 0 ? 6400 : Nsrc;
    constexpr int nkt = K / 64, ntiles = (Ndst / 128) * nkt;
    const int tid = opaque_tid();
    f32x4 cur[4];
    if (bidx < ntiles) tr_load<WHICH>(src, bidx, tid, cur);
    for (int tt = bidx; tt < ntiles; tt += nb) {
        const int ntile = tt / nkt, ktile = tt % nkt;
#pragma unroll
        for (int i = 0; i < 4; ++i) { const int idx = tid + 512 * i; float* tp = tile + (idx >> 5) * 129 + (idx & 31) * 4; tp[0] = cur[i][0]; tp[1] = cur[i][1]; tp[2] = cur[i][2]; tp[3] = cur[i][3]; }
        __syncthreads();
        if (tt + nb < ntiles) tr_load<WHICH>(src, tt + nb, tid, cur);
#pragma unroll
        for (int i = 0; i < 2; ++i) { const int idx = tid + 512 * i, n = idx >> 3, k8 = (idx & 7) * 8;
          const float e0 = tile[(k8 + 0) * 129 + n], e1 = tile[(k8 + 1) * 129 + n], e2 = tile[(k8 + 2) * 129 + n], e3 = tile[(k8 + 3) * 129 + n];
          const float e4 = tile[(k8 + 4) * 129 + n], e5 = tile[(k8 + 5) * 129 + n], e6 = tile[(k8 + 6) * 129 + n], e7 = tile[(k8 + 7) * 129 + n];
          u32x4 o; o.x = pk2(e0, e1); o.y = pk2(e2, e3); o.z = pk2(e4, e5); o.w = pk2(e6, e7);
          *(u32x4*)(dst + (size_t)(ntile * 128 + n) * K + ktile * 64 + k8) = o; }
        __syncthreads();
    }
}
__device__ __forceinline__ void phase_prep(const Params& p, unsigned char* smem) {
    float* sc = (float*)smem;
    float* red = sc + 9 * 1024;
    float* MODS = (float*)(p.ws + OFF_MODS);
    const int tid = opaque_tid();
    bool filled = false;
    for (int u = blockIdx.x; u < 192; u += gridDim.x) {
        if (!filled) {
            for (int e = tid; e < 9 * 1024; e += 512) { const int j = e >> 10, k = e & 1023; const float v = (j == 0) ? p.in[5][k] : p.in[4][(j - 1) * 1024 + k]; sc[e] = silu_f(v); }
            __syncthreads(); filled = true;
        }
        const int layer = u / 96, cb = u % 96;
        const float* W = p.in[layer ? 24 : 6]; const float* bias = p.in[layer ? 25 : 7];
        const int col = cb * 32 + (tid & 31), kg = tid >> 5;
        float acc[9];
#pragma unroll
        for (int j = 0; j < 9; ++j) acc[j] = 0.f;
#pragma unroll 16
        for (int kk = 0; kk < 64; ++kk) { const int k = kg * 64 + kk; const float w = W[(size_t)k * 3072 + col];
#pragma unroll
            for (int j = 0; j < 9; ++j) acc[j] = fmaf(sc[j * 1024 + k], w, acc[j]); }
#pragma unroll
        for (int j = 0; j < 9; ++j) red[(kg * 9 + j) * 32 + (tid & 31)] = acc[j];
        __syncthreads();
        if (tid < 288) { const int j = tid >> 5, c = tid & 31; float s = 0.f;
#pragma unroll
            for (int k2 = 0; k2 < 16; ++k2) s += red[(k2 * 9 + j) * 32 + c];
            MODS[(layer * 9 + j) * 3072 + cb * 32 + c] = s + bias[cb * 32 + c]; }
        __syncthreads();
    }
    __syncthreads();
    { float* tile = (float*)smem;
      const int G = gridDim.x, b = blockIdx.x;
      transpose_tiles<0>(p.in[8], (bf16_t*)(p.ws + OFF_WT0), tile, b, G);
      transpose_tiles<1>(p.in[21], (bf16_t*)(p.ws + OFF_WO0), tile, b, G);
      if (G != 256) {
          transpose_tiles<2>(p.in[26], (bf16_t*)(p.ws + OFF_WT1), tile, b, G);
          transpose_tiles<3>(p.in[31], (bf16_t*)(p.ws + OFF_WO1), tile, b, G); } }
    float* POSR = (float*)(p.ws + OFF_POSR); float* POSC = (float*)(p.ws + OFF_POSC);
    for (int e = blockIdx.x * 512 + tid; e < 80 * 512; e += gridDim.x * 512) {
        const int pos = e >> 9, d = e & 511, i = d & 255;
        const float freq = exp2f(-(float)i * (13.287712379549449f / 256.f));
        const float arg = (float)(pos < 16 ? pos : pos - 16) * freq;
        const float v = d < 256 ? sinf(arg) : cosf(arg);
        if (pos < 16) POSR[pos * 512 + d] = v; else POSC[(pos - 16) * 512 + d] = v;
    }
}

__device__ __forceinline__ void phase_conv_h0(const Params& p, unsigned char* smem) {
    const int tid = opaque_tid();
    const float* MODS = (const float*)(p.ws + OFF_MODS); const float* POSR = (const float*)(p.ws + OFF_POSR); const float* POSC = (const float*)(p.ws + OFF_POSC);
    bf16_t* H = (bf16_t*)(p.ws + OFF_H);
    const int wave = tid >> 6, lane = tid & 63;
    for (int rb = (blockIdx.x * 8 + wave) * 3; rb < NTOK; rb += gridDim.x * 24) {
        f32x4 xv[3][4], pe[3][4];
#pragma unroll
        for (int k = 0; k < 3; ++k) { const int r = rb + k; const float* xr = r < 4096 ? p.in[0] + (size_t)r * 1024 : p.in[1] + (size_t)(r - 4096) * 1024; const int l = (r - 4096) & 1023;
#pragma unroll
            for (int i = 0; i < 4; ++i) { const int c = lane * 4 + 256 * i; xv[k][i] = *(const f32x4*)(xr + c); pe[k][i] = (f32x4){0.f, 0.f, 0.f, 0.f};
                if (r >= 4096) pe[k][i] = *(const f32x4*)(c < 512 ? POSR + (l >> 6) * 512 + c : POSC + (l & 63) * 512 + (c - 512)); } }
#pragma unroll
        for (int k = 0; k < 3; ++k) { const int r = rb + k; const int cond = cond_of_row(r); const float* shift = MODS + cond * 3072; const float* scale = shift + 1024;
#pragma unroll
            for (int i = 0; i < 4; ++i) { const int c = lane * 4 + 256 * i; const f32x4 sc = *(const f32x4*)(scale + c), sh = *(const f32x4*)(shift + c);
                const f32x4 h = (xv[k][i] + pe[k][i]) * (sc + 1.0f) + sh;
                u32x2 o; o.x = pk2(h[0], h[1]); o.y = pk2(h[2], h[3]); *(u32x2*)(H + (size_t)r * 1024 + c) = o; } }
    }
}

struct EpiIn {
    static constexpr bool PERM = true, AFTER_DRAIN = false;
    bf16_t* P; float* DT; float* LNP;
    __device__ __forceinline__ void operator()(const f32x4 (&acc)[2][2][4][2], const pg8::Unit& u, int wr, int wc, int fr, int fq) const {
        const int row0 = u.pm * 256 + wr * 64 + fr;
        const bool l0 = LNP == nullptr;
        if (l0 && u.pn >= 12 && u.pn < 20) {
            const int col0 = 3072 + (u.pn - 12) * 128 + wc * 32 + 8 * fq;
#pragma unroll
            for (int ai = 0; ai < 2; ++ai)
#pragma unroll
                for (int m = 0; m < 4; ++m) { const f32x4 v0 = acc[ai][0][m][0], v1 = acc[ai][0][m][1], g0 = acc[ai][1][m][0], g1 = acc[ai][1][m][1];
                    u32x4 w; w.x = pk2(v0[0] * sigmoid_f(g0[0]), v0[1] * sigmoid_f(g0[1])); w.y = pk2(v0[2] * sigmoid_f(g0[2]), v0[3] * sigmoid_f(g0[3]));
                    w.z = pk2(v1[0] * sigmoid_f(g1[0]), v1[1] * sigmoid_f(g1[1])); w.w = pk2(v1[2] * sigmoid_f(g1[2]), v1[3] * sigmoid_f(g1[3]));
                    *(u32x4*)(P + (size_t)(row0 + ai * 128 + m * 16) * 6144 + col0) = w; }
        } else if (u.pn < 24) {
            const int col0 = u.pn * 256 + wc * 32 + 8 * fq;
            const bool act = l0 ? (u.pn < 4 || u.pn >= 20) : (u.pn >= 16);
#pragma unroll
            for (int ai = 0; ai < 2; ++ai)
#pragma unroll
                for (int m = 0; m < 4; ++m) { bf16_t* rowp = P + (size_t)(row0 + ai * 128 + m * 16) * 6144 + col0;
#pragma unroll
                    for (int bj = 0; bj < 2; ++bj) { f32x4 v0 = acc[ai][bj][m][0], v1 = acc[ai][bj][m][1];
                        if (act) {
#pragma unroll
                            for (int e = 0; e < 4; ++e) { v0[e] = silu_f(v0[e]); v1[e] = silu_f(v1[e]); } }
                        u32x4 w; w.x = pk2(v0[0], v0[1]); w.y = pk2(v0[2], v0[3]); w.z = pk2(v1[0], v1[1]); w.w = pk2(v1[2], v1[3]);
                        *(u32x4*)(rowp + bj * 128) = w; } }
            if (!l0 && u.pn >= 8 && u.pn < 16) {
#pragma unroll
                for (int ai = 0; ai < 2; ++ai)
#pragma unroll
                    for (int m = 0; m < 4; ++m) { float s1 = 0.f, s2 = 0.f;
#pragma unroll
                        for (int bj = 0; bj < 2; ++bj)
#pragma unroll
                            for (int n = 0; n < 2; ++n)
#pragma unroll
                                for (int e = 0; e < 4; ++e) { const float v = acc[ai][bj][m][n][e]; s1 += v; s2 = fmaf(v, v, s2); }
                        s1 += __shfl_xor(s1, 16); s2 += __shfl_xor(s2, 16); s1 += __shfl_xor(s1, 32); s2 += __shfl_xor(s2, 32);
                        if (fq == 0) { f32x2v o; o.x = s1; o.y = s2; *(f32x2v*)(LNP + ((size_t)(row0 + ai * 128 + m * 16) * 32 + (u.pn - 8) * 4 + wc) * 2) = o; } }
            }
        } else if (wc == 0) {
#pragma unroll
            for (int ai = 0; ai < 2; ++ai)
#pragma unroll
                for (int m = 0; m < 4; ++m) { float* rowp = DT + (size_t)(row0 + ai * 128 + m * 16) * 32 + 8 * fq;
                    *(f32x4*)rowp = acc[ai][0][m][0]; *(f32x4*)(rowp + 4) = acc[ai][0][m][1]; }
        }
    }
};
struct EpiOut {
    static constexpr bool PERM = true, AFTER_DRAIN = false;
    bf16_t* Y; const float* gate;
    __device__ __forceinline__ void operator()(const f32x4 (&acc)[2][2][4][2], const pg8::Unit& u, int wr, int wc, int fr, int fq) const {
        const int row0 = u.pm * 256 + wr * 64 + fr, col0 = u.pn * 256 + wc * 32 + 8 * fq;
        const int cond = u.pm < 16 ? 0 : 1 + ((u.pm - 16) >> 2);
        f32x4 gv[2][2];
#pragma unroll
        for (int bj = 0; bj < 2; ++bj)
#pragma unroll
            for (int n = 0; n < 2; ++n) gv[bj][n] = *(const f32x4*)(gate + cond * 3072 + col0 + bj * 128 + n * 4);
#pragma unroll
        for (int ai = 0; ai < 2; ++ai)
#pragma unroll
            for (int m = 0; m < 4; ++m) { bf16_t* rowp = Y + (size_t)(row0 + ai * 128 + m * 16) * 1024 + col0;
#pragma unroll
                for (int bj = 0; bj < 2; ++bj) { const f32x4 v0 = acc[ai][bj][m][0] * gv[bj][0], v1 = acc[ai][bj][m][1] * gv[bj][1];
                    u32x4 w; w.x = pk2(v0[0], v0[1]); w.y = pk2(v0[2], v0[3]); w.z = pk2(v1[0], v1[1]); w.w = pk2(v1[2], v1[3]);
                    *(u32x4*)(rowp + bj * 128) = w; } }
    }
};

__device__ __forceinline__ void conformer_unit(const Params& p, unsigned char* smem, int unit) {
    const int tid = opaque_tid(), row_base = unit * 16;
    int seq0, L; if (row_base < 4096) { seq0 = row_base & ~255; L = 256; } else { seq0 = 4096 + ((row_base - 4096) & ~1023); L = 1024; }
    const int t0 = row_base - seq0, c0 = tid * 2;
    const bf16_t* P = (const bf16_t*)(p.ws + OFF_P); bf16_t* YC = (bf16_t*)(p.ws + OFF_YC);
    float w[31][2];
#pragma unroll
    for (int k = 0; k < 31; ++k) { const f32x2v v = *(const f32x2v*)(p.in[17] + k * 1024 + c0); w[k][0] = v.x; w[k][1] = v.y; }
    float acc[16][2];
    { const f32x2v b = *(const f32x2v*)(p.in[18] + c0);
#pragma unroll
      for (int tt = 0; tt < 16; ++tt) { acc[tt][0] = b.x; acc[tt][1] = b.y; } }
    const bf16_t* Pv = P + 3072 + c0;
    unsigned gtv[16];
#pragma unroll
    for (int tt = 0; tt < 16; ++tt) gtv[tt] = *(const unsigned*)(P + (size_t)(row_base + tt) * 6144 + 5120 + c0);
    unsigned uraw[46];
#pragma unroll
    for (int jr = 0; jr < 46; ++jr) { const int t = t0 - 15 + jr, tc = t < 0 ? 0 : (t >= L ? L - 1 : t); uraw[jr] = *(const unsigned*)(Pv + (size_t)(seq0 + tc) * 6144); }
#pragma unroll
    for (int jr = 0; jr < 46; ++jr) {
        const int t = t0 - 15 + jr; const bool ok = t >= 0 && t < L; const float u0 = ok ? bflo(uraw[jr]) : 0.f, u1 = ok ? bfhi(uraw[jr]) : 0.f;
#pragma unroll
        for (int tt = 0; tt < 16; ++tt) { const int k = jr - tt; if (k >= 0 && k < 31) { acc[tt][0] = fmaf(w[k][0], u0, acc[tt][0]); acc[tt][1] = fmaf(w[k][1], u1, acc[tt][1]); } }
    }
    float* red1 = (float*)smem; float* red2 = red1 + 16 * 512; float* stat = red2 + 16 * 512;
#pragma unroll
    for (int tt = 0; tt < 16; ++tt) { red1[tt * 512 + tid] = acc[tt][0] + acc[tt][1]; red2[tt * 512 + tid] = acc[tt][0] * acc[tt][0] + acc[tt][1] * acc[tt][1]; }
    __syncthreads();
    { const int tt = tid >> 5, q = tid & 31; float s1 = 0.f, s2 = 0.f;
#pragma unroll
      for (int i = 0; i < 16; ++i) { s1 += red1[tt * 512 + q + 32 * i]; s2 += red2[tt * 512 + q + 32 * i]; }
#pragma unroll
      for (int o = 1; o < 32; o <<= 1) { s1 += __shfl_xor(s1, o); s2 += __shfl_xor(s2, o); }
      const float mean = s1 * (1.f / 1024.f), var = fmaxf(s2 * (1.f / 1024.f) - mean * mean, 0.f);
      if (q == 0) { stat[tt * 2] = mean; stat[tt * 2 + 1] = rsqrtf(var + 1e-5f); } }
    __syncthreads();
    const f32x2v lg = *(const f32x2v*)(p.in[19] + c0), lb = *(const f32x2v*)(p.in[20] + c0);
#pragma unroll
    for (int tt = 0; tt < 16; ++tt) {
        const int row = row_base + tt; const float mean = stat[tt * 2], rstd = stat[tt * 2 + 1];
        const unsigned gt = gtv[tt];
        float v0 = (acc[tt][0] - mean) * rstd * lg.x + lb.x, v1 = (acc[tt][1] - mean) * rstd * lg.y + lb.y;
        v0 = silu_f(v0) * bflo(gt); v1 = silu_f(v1) * bfhi(gt);
        *(unsigned*)(YC + (size_t)row * 2048 + 1024 + c0) = pk2(v0, v1);
    }
    __syncthreads();
}

struct DtRaw { float bias, alog, r0, r1; };
__device__ __forceinline__ DtRaw dt_load(const Params& p, int row0, int g, int tid) {
    const int wave = tid >> 6, lane = tid & 63, hh = wave >> 1, dir = wave & 1, h = g * 4 + hh;
    const float* DT = (const float*)(p.ws + OFF_DT) + (size_t)row0 * 32 + dir * 16 + h;
    DtRaw d; d.bias = p.in[dir ? 12 : 11][h]; d.alog = p.in[dir ? 14 : 13][h]; d.r0 = DT[(2 * lane) * 32]; d.r1 = DT[(2 * lane + 1) * 32]; return d;
}
__device__ __forceinline__ void dt_compute(const DtRaw& d, float* vdt, float* vcum, int tid, float* vw = nullptr) {
    const int wave = tid >> 6, lane = tid & 63, hh = wave >> 1, dir = wave & 1;
    const float a = -expf(d.alog);
    const float d0 = softplus_f(d.r0 + d.bias), d1 = softplus_f(d.r1 + d.bias);
    const float v0 = d0 * a, v1 = d1 * a, s = v0 + v1;
    float inc = s;
#pragma unroll
    for (int o = 1; o < 64; o <<= 1) { const float t = __shfl_up(inc, o); if (lane >= o) inc += t; }
    const float exc = inc - s, P0 = exc + v0;
    float* cd = vcum + (hh * 2 + dir) * 128; float* dd = vdt + (hh * 2 + dir) * 128;
    if (dir == 0) { cd[2 * lane] = P0; cd[2 * lane + 1] = inc; }
    else { const float total = __shfl(inc, 63); cd[2 * lane] = total - exc; cd[2 * lane + 1] = total - P0; }
    dd[2 * lane] = d0; dd[2 * lane + 1] = d1;
    if (vw != nullptr) {
        float* wd = vw + (hh * 2 + dir) * 128;
        if (dir == 0) { const float pe = __shfl(inc, (lane & ~7) | 7); wd[2 * lane] = __expf(pe - P0) * d0; wd[2 * lane + 1] = __expf(pe - inc) * d1; }
        else { const float total = __shfl(inc, 63), s0 = total - exc, s1 = total - P0, sb = __shfl(s0, lane & ~7); wd[2 * lane] = __expf(sb - s0) * d0; wd[2 * lane + 1] = __expf(sb - s1) * d1; }
    }
}
struct CwRaw { f32x4 w0, w1; float ad; };
__device__ __forceinline__ const float* conv_w_src(const Params& p, int g, int q) { const int k = q >> 7, c4 = (q & 127) * 4;
    const int gch = c4 < 256 ? g * 256 + c4 : (c4 < 384 ? 1024 + g * 128 + (c4 - 256) : 1536 + g * 128 + (c4 - 384));
    return k < 4 ? p.in[9] + k * 2048 + gch : p.in[10] + gch; }
__device__ __forceinline__ CwRaw conv_w_load(const Params& p, int g, int tid) {
    CwRaw r; r.w0 = *(const f32x4*)conv_w_src(p, g, tid); r.w1 = *(const f32x4*)conv_w_src(p, g, 512 + (tid & 127)); r.ad = p.in[15][g * 4 + (tid & 3)]; return r;
}
__device__ __forceinline__ void conv_w_store(const CwRaw& r, float* cwl, int tid) {
    *(f32x4*)(cwl + (tid >> 7) * 512 + (tid & 127) * 4) = r.w0;
    if (tid < 128) *(f32x4*)(cwl + 2048 + tid * 4) = r.w1;
    if (tid < 4) cwl[2560 + tid] = r.ad;
}
__device__ __forceinline__ void conv_load4(const bf16_t* P, int seq0, int L, int row0, int j0, int cc0, u32x4 (&raw)[7]) {
#pragma unroll
    for (int rr = 0; rr < 7; ++rr) { const int grow = row0 + j0 - 2 + rr, gc = grow < seq0 ? seq0 : (grow >= seq0 + L ? seq0 + L - 1 : grow);
        const u32x4 v = *(const u32x4*)(P + (size_t)gc * 6144 + 1024 + cc0); raw[rr] = (grow == gc) ? v : (u32x4){0u, 0u, 0u, 0u}; }
}
__device__ __forceinline__ void conv_compute4(const float* cwl, int lc0, const u32x4 (&raw)[7], float (&out)[4][8]) {
    float w[4][8], b[8];
#pragma unroll
    for (int k = 0; k < 4; ++k) { const f32x4 a = *(const f32x4*)(cwl + k * 512 + lc0), c = *(const f32x4*)(cwl + k * 512 + lc0 + 4);
        w[k][0] = a[0]; w[k][1] = a[1]; w[k][2] = a[2]; w[k][3] = a[3]; w[k][4] = c[0]; w[k][5] = c[1]; w[k][6] = c[2]; w[k][7] = c[3]; }
    { const f32x4 a = *(const f32x4*)(cwl + 2048 + lc0), c = *(const f32x4*)(cwl + 2048 + lc0 + 4); b[0] = a[0]; b[1] = a[1]; b[2] = a[2]; b[3] = a[3]; b[4] = c[0]; b[5] = c[1]; b[6] = c[2]; b[7] = c[3]; }
#pragma unroll
    for (int jj = 0; jj < 4; ++jj) {
        float a[8];
#pragma unroll
        for (int e = 0; e < 8; ++e) a[e] = b[e];
#pragma unroll
        for (int k = 0; k < 4; ++k) { float x[8]; unpack8(raw[jj + k], x);
#pragma unroll
            for (int e = 0; e < 8; ++e) a[e] = fmaf(w[k][e], x[e], a[e]); }
#pragma unroll
        for (int e = 0; e < 8; ++e) out[jj][e] = silu_f(a[e]);
    }
}
__device__ __forceinline__ void seq_of_row(int row0, int& seq0, int& L) { if (row0 < 4096) { seq0 = row0 & ~255; L = 256; } else { seq0 = 4096 + ((row0 - 4096) & ~1023); L = 1024; } }

__device__ __forceinline__ void sstate_unit(const Params& p, unsigned char* smem, int unit) {
    const int tid = opaque_tid(), wave = tid >> 6, lane = tid & 63, fr = lane & 15, fq = lane >> 4;
    const int cgi = unit >> 2, g = unit & 3, row0 = cgi * 128; int seq0, L; seq_of_row(row0, seq0, L);
    const bf16_t* P = (const bf16_t*)(p.ws + OFF_P); bf16_t* SST = (bf16_t*)p.out; float* DEC = (float*)(p.ws + OFF_DEC);
    bf16_t* BT = (bf16_t*)smem; bf16_t* XTf = BT + 128 * LDP; bf16_t* XTb = XTf + 128 * LDP; float* vdt = (float*)(smem + 104448); float* vcum = (float*)(smem + 108544);
    float* cwl = (float*)(smem + 112640);
    const int chl = (tid & 15) * 8, j0 = (tid >> 4) * 4;
    u32x4 rawB[7], rawX[7], rawC[7];
    bf16_t* CVX = (bf16_t*)(p.ws + OFF_P) + 4096 + g * 256; bf16_t* CVBC = (bf16_t*)(p.ws + OFF_H) + g * 128;
    const DtRaw dtr = dt_load(p, row0, g, tid);
    const CwRaw cwr = conv_w_load(p, g, tid);
    conv_load4(P, seq0, L, row0, j0, 1024 + g * 128 + chl, rawB);
    conv_load4(P, seq0, L, row0, j0, 1536 + g * 128 + chl, rawC);
    conv_load4(P, seq0, L, row0, j0, g * 256 + chl, rawX);
    conv_w_store(cwr, cwl, tid);
    dt_compute(dtr, vdt, vcum, tid);
    __syncthreads();
    if (tid < 8) { const int hh = tid >> 1, dir = tid & 1; DEC[(cgi * 16 + g * 4 + hh) * 2 + dir] = expf(dir == 0 ? vcum[(hh * 2) * 128 + 127] : vcum[(hh * 2 + 1) * 128]); }
#pragma unroll
    for (int pair = 0; pair < 2; ++pair) {
        if (pair) __syncthreads();
#ifdef DUP_SCONV
#pragma unroll 1
        for (int rep_ = 0; rep_ < 2; ++rep_) { asm volatile("" ::: "memory");
#endif
        { if (pair == 0) {
              float o[4][8]; conv_compute4(cwl, 256 + chl, rawB, o);
#pragma unroll
              for (int e = 0; e < 8; ++e) { u32x2 a; a.x = pk2(o[0][e], o[1][e]); a.y = pk2(o[2][e], o[3][e]); *(u32x2*)(BT + swz(chl + e, j0)) = a; }
#pragma unroll
              for (int jj = 0; jj < 4; ++jj) { u32x4 a; a.x = pk2(o[jj][0], o[jj][1]); a.y = pk2(o[jj][2], o[jj][3]); a.z = pk2(o[jj][4], o[jj][5]); a.w = pk2(o[jj][6], o[jj][7]);
                  *(u32x4*)(CVBC + (size_t)(row0 + j0 + jj) * 1024 + chl) = a; }
              conv_compute4(cwl, 384 + chl, rawC, o);
#pragma unroll
              for (int jj = 0; jj < 4; ++jj) { u32x4 a; a.x = pk2(o[jj][0], o[jj][1]); a.y = pk2(o[jj][2], o[jj][3]); a.z = pk2(o[jj][4], o[jj][5]); a.w = pk2(o[jj][6], o[jj][7]);
                  *(u32x4*)(CVBC + (size_t)(row0 + j0 + jj) * 1024 + 512 + chl) = a; }
          }
          const int hh = pair * 2 + (chl >> 6);
          float o[4][8]; conv_compute4(cwl, pair * 128 + chl, rawX, o);
#pragma unroll
          for (int jj = 0; jj < 4; ++jj) { u32x4 a; a.x = pk2(o[jj][0], o[jj][1]); a.y = pk2(o[jj][2], o[jj][3]); a.z = pk2(o[jj][4], o[jj][5]); a.w = pk2(o[jj][6], o[jj][7]);
              *(u32x4*)(CVX + (size_t)(row0 + j0 + jj) * 6144 + pair * 128 + chl) = a; }
          float wf[4], wb[4]; const float pf127 = vcum[(hh * 2) * 128 + 127], sb0 = vcum[(hh * 2 + 1) * 128];
#pragma unroll
          for (int jj = 0; jj < 4; ++jj) { wf[jj] = vdt[(hh * 2) * 128 + j0 + jj] * __expf(pf127 - vcum[(hh * 2) * 128 + j0 + jj]); wb[jj] = vdt[(hh * 2 + 1) * 128 + j0 + jj] * __expf(sb0 - vcum[(hh * 2 + 1) * 128 + j0 + jj]); }
#pragma unroll
          for (int e = 0; e < 8; ++e) { u32x2 a, c;
              a.x = pk2(o[0][e] * wf[0], o[1][e] * wf[1]); a.y = pk2(o[2][e] * wf[2], o[3][e] * wf[3]);
              c.x = pk2(o[0][e] * wb[0], o[1][e] * wb[1]); c.y = pk2(o[2][e] * wb[2], o[3][e] * wb[3]);
              *(u32x2*)(XTf + swz(chl + e, j0)) = a; *(u32x2*)(XTb + swz(chl + e, j0)) = c; }
        }
#ifdef DUP_SCONV
        }
#endif
        __syncthreads();
        if (pair == 0) conv_load4(P, seq0, L, row0, j0, g * 256 + 128 + chl, rawX);
        const int hd = wave >> 1, hl = hd >> 1, dir = hd & 1, nhalf = wave & 1;
        const bf16_t* XT = (dir ? XTb : XTf);
        f32x4 acc[4][4];
#pragma unroll
        for (int m = 0; m < 4; ++m)
#pragma unroll
            for (int nt = 0; nt < 4; ++nt) acc[m][nt] = (f32x4){0.f, 0.f, 0.f, 0.f};
#pragma unroll
        for (int ks = 0; ks < 4; ++ks) { bf16x8 a[4], b[4];
#pragma unroll
            for (int m = 0; m < 4; ++m) a[m] = *(const bf16x8*)(XT + swz(hl * 64 + m * 16 + fr, ks * 32 + fq * 8));
#pragma unroll
            for (int nt = 0; nt < 4; ++nt) b[nt] = *(const bf16x8*)(BT + swz(nhalf * 64 + nt * 16 + fr, ks * 32 + fq * 8));
#pragma unroll
            for (int m = 0; m < 4; ++m)
#pragma unroll
                for (int nt = 0; nt < 4; ++nt) acc[m][nt] = mfma16(b[nt], a[m], acc[m][nt]); }
        bf16_t* S = SST + ((size_t)(cgi * 16 + g * 4 + pair * 2 + hl) * 2 + dir) * 8192;
#pragma unroll
        for (int m = 0; m < 4; ++m)
#pragma unroll
            for (int nt = 0; nt < 4; ++nt) { u32x2 o; o.x = pk2(acc[m][nt][0], acc[m][nt][1]); o.y = pk2(acc[m][nt][2], acc[m][nt][3]);
                *(u32x2*)(S + (m * 16 + fr) * 128 + nhalf * 64 + nt * 16 + 4 * fq) = o; }
    }
    __syncthreads();
}


__device__ __forceinline__ void prefix_phase(const Params& p) {
    const int tid = opaque_tid();
    bf16_t* SST = (bf16_t*)p.out; const float* DEC = (const float*)(p.ws + OFF_DEC);
    for (int task = blockIdx.x; task < 1536; task += gridDim.x) {
        const int item = task >> 1, s = item >> 5, h = (item >> 1) & 15, dir = item & 1, e8 = ((task & 1) * 512 + tid) * 8;
        const int cg0 = s < 16 ? s * 2 : 32 + (s - 16) * 8, nc = s < 16 ? 2 : 8;
        float hv[8];
        if (s >= 16) { const float* h0 = p.in[dir ? 3 : 2] + (size_t)((s - 16) * 16 + h) * 8192 + e8; const f32x4 a = *(const f32x4*)h0, c = *(const f32x4*)(h0 + 4);
            hv[0] = a[0]; hv[1] = a[1]; hv[2] = a[2]; hv[3] = a[3]; hv[4] = c[0]; hv[5] = c[1]; hv[6] = c[2]; hv[7] = c[3]; }
        else {
#pragma unroll
            for (int e = 0; e < 8; ++e) hv[e] = 0.f; }
        u32x4 sv[8]; float dc[8];
#pragma unroll
        for (int k = 0; k < 8; ++k) { sv[k] = (u32x4){0u, 0u, 0u, 0u}; dc[k] = 0.f;
            if (k < nc) { const int c = dir ? nc - 1 - k : k; const size_t idx = (size_t)((cg0 + c) * 16 + h) * 2 + dir; sv[k] = *(const u32x4*)(SST + idx * 8192 + e8); dc[k] = DEC[idx]; } }
#pragma unroll
        for (int k = 0; k < 8; ++k) {
            if (k < nc) { const int c = dir ? nc - 1 - k : k; const size_t idx = (size_t)((cg0 + c) * 16 + h) * 2 + dir;
                u32x4 o; o.x = pk2(hv[0], hv[1]); o.y = pk2(hv[2], hv[3]); o.z = pk2(hv[4], hv[5]); o.w = pk2(hv[6], hv[7]);
                *(u32x4*)(SST + idx * 8192 + e8) = o;
                float x[8]; unpack8(sv[k], x);
#pragma unroll
                for (int e = 0; e < 8; ++e) hv[e] = fmaf(hv[e], dc[k], x[e]); } }
        if (s < 16) { float* o = p.out + (dir ? OUT_STB : OUT_STF) + (size_t)(s * 16 + h) * 8192 + e8;
            *(f32x4*)o = (f32x4){hv[0], hv[1], hv[2], hv[3]}; *(f32x4*)(o + 4) = (f32x4){hv[4], hv[5], hv[6], hv[7]}; }
    }
}

__device__ __forceinline__ void ssd_y_unit(const Params& p, unsigned char* smem, int unit) {
    const int tid = opaque_tid(), wave = tid >> 6, lane = tid & 63, fr = lane & 15, fq = lane >> 4;
    const int cgi = unit >> 2, g = unit & 3, row0 = cgi * 128; int seq0, L; seq_of_row(row0, seq0, L);
    const int cidx = (row0 - seq0) >> 7, nc = L >> 7, cg0 = seq0 >> 7; const bool is_sample = row0 >= 4096; const int bs = (row0 - 4096) >> 10;
    const bf16_t* P = (const bf16_t*)(p.ws + OFF_P); const bf16_t* SST = (const bf16_t*)p.out; const float* DEC = (const float*)(p.ws + OFF_DEC); bf16_t* YC = (bf16_t*)(p.ws + OFF_YC);
    bf16_t* Cs = (bf16_t*)smem; bf16_t* BM = Cs + 128 * LDP; bf16_t* XT = BM + 128 * LDP; bf16_t* Hf = XT + 64 * LDP; bf16_t* Hb = Hf + 64 * LDP;
    float* vdt = (float*)(smem + 121856); float* vcum = (float*)(smem + 125952);
    float* cwl = (float*)(smem + 130048);
    const bf16_t* CVX = (const bf16_t*)(p.ws + OFF_P) + 4096 + g * 256; const bf16_t* CVBC = (const bf16_t*)(p.ws + OFF_H) + g * 128;
    const int i = wave * 16 + fr;
    f32x4 cb[8];
#ifdef DUP_TOP
#pragma unroll 1
    for (int rep_ = 0; rep_ < 2; ++rep_) { asm volatile("" ::: "memory");
#endif
    { const int chl = (tid & 15) * 8, j0 = (tid >> 4) * 4;
      const DtRaw dtr = dt_load(p, row0, g, tid);
      const float adv = p.in[15][g * 4 + (tid & 3)];
      u32x4 cC[4], cB[4];
#pragma unroll
      for (int jj = 0; jj < 4; ++jj) { cC[jj] = *(const u32x4*)(CVBC + (size_t)(row0 + j0 + jj) * 1024 + 512 + chl); cB[jj] = *(const u32x4*)(CVBC + (size_t)(row0 + j0 + jj) * 1024 + chl); }
      if (tid < 4) cwl[2560 + tid] = adv;
      dt_compute(dtr, vdt, vcum, tid, cwl);
#pragma unroll
      for (int jj = 0; jj < 4; ++jj) { *(u32x4*)(Cs + (j0 + jj) * LDP + chl) = cC[jj]; *(u32x4*)(BM + (j0 + jj) * LDP + chl) = cB[jj]; } }
    __syncthreads();
#ifndef DUP_TOP
    float ssq = 0.f;
    const int grow = row0 + i; const int wave_u = __builtin_amdgcn_readfirstlane(wave);
    const int xchl = (tid & 15) * 4, xj0 = (tid >> 4) * 4;
    u32x4 hin[4]; u32x2 rawx[4]; u32x4 zz[2];
#define Y_LOAD_HEAD(HH) do { const int h_ = g * 4 + (HH); \
        _Pragma("unroll") for (int it = 0; it < 4; ++it) { const int v = tid + 512 * it, dir = v >> 10, e8 = (v & 1023) * 8; hin[it] = *(const u32x4*)(SST + ((size_t)(cgi * 16 + h_) * 2 + dir) * 8192 + e8); } \
        _Pragma("unroll") for (int jj = 0; jj < 4; ++jj) rawx[jj] = *(const u32x2*)(CVX + (size_t)(row0 + xj0 + jj) * 6144 + (HH) * 64 + xchl); \
        _Pragma("unroll") for (int t = 0; t < 2; ++t) zz[t] = *(const u32x4*)(P + (size_t)grow * 6144 + h_ * 64 + t * 32 + 8 * fq); } while (0)
    Y_LOAD_HEAD(0);
#endif
#pragma unroll
    for (int nt = 0; nt < 8; ++nt) cb[nt] = (f32x4){0.f, 0.f, 0.f, 0.f};
#pragma unroll
    for (int ks = 0; ks < 4; ++ks) { const bf16x8 a = *(const bf16x8*)(Cs + i * LDP + ks * 32 + fq * 8);
#pragma unroll
        for (int nt = 0; nt < 8; ++nt) { const bf16x8 b = *(const bf16x8*)(BM + (nt * 16 + fr) * LDP + ks * 32 + fq * 8); cb[nt] = mfma16(b, a, cb[nt]); } }
    __syncthreads();
#ifdef DUP_TOP
    }
#endif
#pragma unroll 1
    for (int hh = 0; hh < 4; ++hh) {
        const int h = g * 4 + hh;
        const float pfi = vcum[(hh * 2) * 128 + i], sbi = vcum[(hh * 2 + 1) * 128 + i];
#ifdef DUP_M
#pragma unroll 1
        for (int rep_ = 0; rep_ < 2; ++rep_) { asm volatile("" ::: "memory");
#endif
#pragma unroll
        for (int nt = 0; nt < 8; ++nt) { const int j0 = nt * 16 + 4 * fq; float mv[4];
            if (nt == wave_u) {
                const f32x4 pfj = *(const f32x4*)(vcum + (hh * 2) * 128 + j0), sbj = *(const f32x4*)(vcum + (hh * 2 + 1) * 128 + j0);
                const f32x4 dfj = *(const f32x4*)(vdt + (hh * 2) * 128 + j0), dbj = *(const f32x4*)(vdt + (hh * 2 + 1) * 128 + j0);
#pragma unroll
                for (int r = 0; r < 4; ++r) { const int j = j0 + r; const float arg = j < i ? pfi - pfj[r] : sbi - sbj[r]; const float ex = __expf(fminf(arg, 0.f));
                    const float m = j < i ? ex * dfj[r] : (j > i ? ex * dbj[r] : dfj[r] + dbj[r]); mv[r] = m * cb[nt][r]; }
            } else {
                const bool lower = nt < wave_u;
                const float e1 = __expf(fminf(lower ? pfi - vcum[(hh * 2) * 128 + nt * 16 + 15] : sbi - vcum[(hh * 2 + 1) * 128 + nt * 16], 0.f));
                const f32x4 wj = *(const f32x4*)(cwl + (hh * 2 + (lower ? 0 : 1)) * 128 + j0);
#pragma unroll
                for (int r = 0; r < 4; ++r) mv[r] = cb[nt][r] * (e1 * wj[r]);
            }
            u32x2 o; o.x = pk2(mv[0], mv[1]); o.y = pk2(mv[2], mv[3]);
            *(u32x2*)(BM + i * LDP + j0) = o; }
#ifdef DUP_M
        }
#endif
#ifdef DUP_STG
#pragma unroll 1
        for (int rep_ = 0; rep_ < 2; ++rep_) { asm volatile("" ::: "memory");
#endif
#pragma unroll
        for (int it = 0; it < 4; ++it) { const int v = tid + 512 * it, dir = v >> 10, e8 = (v & 1023) * 8, pp = e8 >> 7;
            const int rho = (pp & ~31) + 16 * ((pp >> 2) & 1) + 4 * ((pp & 31) >> 3) + (pp & 3);
            *(u32x4*)((dir ? Hb : Hf) + rho * LDP + (e8 & 127)) = hin[it]; }
        {
          u32x2 t0, t1, t2, t3;
          t0.x = __builtin_amdgcn_perm(rawx[1].x, rawx[0].x, 0x05040100u); t0.y = __builtin_amdgcn_perm(rawx[3].x, rawx[2].x, 0x05040100u);
          t1.x = __builtin_amdgcn_perm(rawx[1].x, rawx[0].x, 0x07060302u); t1.y = __builtin_amdgcn_perm(rawx[3].x, rawx[2].x, 0x07060302u);
          t2.x = __builtin_amdgcn_perm(rawx[1].y, rawx[0].y, 0x05040100u); t2.y = __builtin_amdgcn_perm(rawx[3].y, rawx[2].y, 0x05040100u);
          t3.x = __builtin_amdgcn_perm(rawx[1].y, rawx[0].y, 0x07060302u); t3.y = __builtin_amdgcn_perm(rawx[3].y, rawx[2].y, 0x07060302u);
          const int xr = (xchl & ~31) + 16 * ((xchl >> 2) & 1) + 4 * ((xchl & 31) >> 3);
          *(u32x2*)(XT + swz(xr + 0, xj0)) = t0; *(u32x2*)(XT + swz(xr + 1, xj0)) = t1; *(u32x2*)(XT + swz(xr + 2, xj0)) = t2; *(u32x2*)(XT + swz(xr + 3, xj0)) = t3; }
#ifdef DUP_STG
        }
#endif
        u32x4 zc[2];
#pragma unroll
        for (int t = 0; t < 2; ++t) zc[t] = zz[t];
        __syncthreads();
        if (hh < 3) Y_LOAD_HEAD(hh + 1);
#ifdef DUP_LD
        asm volatile("" ::: "memory"); if (hh < 3) Y_LOAD_HEAD(hh + 1);
#endif
        f32x4 yd[4], tf[4], tb[4];
#pragma unroll
        for (int nt = 0; nt < 4; ++nt) { yd[nt] = (f32x4){0.f, 0.f, 0.f, 0.f}; tf[nt] = yd[nt]; tb[nt] = yd[nt]; }
#ifdef DUP_MFMA
#pragma unroll 1
        for (int rep_ = 0; rep_ < 2; ++rep_) { asm volatile("" ::: "memory");
#endif
#pragma unroll 2
        for (int ks = 0; ks < 4; ++ks) { const bf16x8 am = *(const bf16x8*)(BM + i * LDP + ks * 32 + fq * 8), ac = *(const bf16x8*)(Cs + i * LDP + ks * 32 + fq * 8);
#pragma unroll
            for (int nt = 0; nt < 4; ++nt) { const int ro = (nt * 16 + fr) * LDP + ks * 32 + fq * 8;
                yd[nt] = mfma16(*(const bf16x8*)(XT + swz(nt * 16 + fr, ks * 32 + fq * 8)), am, yd[nt]); tf[nt] = mfma16(*(const bf16x8*)(Hf + ro), ac, tf[nt]); tb[nt] = mfma16(*(const bf16x8*)(Hb + ro), ac, tb[nt]); } }
#ifdef DUP_MFMA
        }
#pragma unroll
        for (int nt = 0; nt < 4; ++nt) { yd[nt] *= 0.5f; tf[nt] *= 0.5f; tb[nt] *= 0.5f; }
#endif
        const float ef = __expf(pfi), eb = __expf(sbi), ad = cwl[2560 + hh];
#ifdef DUP_COMB
        float ssq_keep = ssq;
#pragma unroll 1
        for (int rep_ = 0; rep_ < 2; ++rep_) { asm volatile("" ::: "memory"); if (rep_ == 1) ssq = ssq_keep;
#endif
#pragma unroll
        for (int t = 0; t < 2; ++t) { float zf[8]; unpack8(zc[t], zf); float yv[8];
#pragma unroll
            for (int n = 0; n < 2; ++n)
#pragma unroll
                for (int r = 0; r < 4; ++r) { const int nt = 2 * t + n; const float x = bf2f(XT[swz(nt * 16 + 4 * fq + r, i)]);
                    float y = yd[nt][r] + ef * tf[nt][r] + eb * tb[nt][r] + ad * x; y *= zf[4 * n + r]; ssq = fmaf(y, y, ssq); yv[4 * n + r] = y; }
            u32x4 o; o.x = pk2(yv[0], yv[1]); o.y = pk2(yv[2], yv[3]); o.z = pk2(yv[4], yv[5]); o.w = pk2(yv[6], yv[7]);
            *(u32x4*)(YC + (size_t)grow * 2048 + h * 64 + t * 32 + 8 * fq) = o; }
#ifdef DUP_COMB
        }
#endif
        __syncthreads();
    }
#undef Y_LOAD_HEAD
    ssq += __shfl_xor(ssq, 16); ssq += __shfl_xor(ssq, 32);
    const float rs = rsqrtf(ssq * (1.f / 256.f) + 1e-5f);
    { u32x4 yy[4][2]; f32x4 nwv[4][2][2];
#pragma unroll
      for (int hh = 0; hh < 4; ++hh)
#pragma unroll
          for (int t = 0; t < 2; ++t) { const int ch = g * 256 + hh * 64 + t * 32 + 8 * fq; yy[hh][t] = *(const u32x4*)(YC + (size_t)grow * 2048 + ch);
              nwv[hh][t][0] = *(const f32x4*)(p.in[16] + ch); nwv[hh][t][1] = *(const f32x4*)(p.in[16] + ch + 4); }
#pragma unroll
      for (int hh = 0; hh < 4; ++hh)
#pragma unroll
          for (int t = 0; t < 2; ++t) { const int ch = g * 256 + hh * 64 + t * 32 + 8 * fq; float yf[8]; unpack8(yy[hh][t], yf); const f32x4 n0 = nwv[hh][t][0], n1 = nwv[hh][t][1];
              u32x4 o; o.x = pk2(yf[0] * rs * n0[0], yf[1] * rs * n0[1]); o.y = pk2(yf[2] * rs * n0[2], yf[3] * rs * n0[3]); o.z = pk2(yf[4] * rs * n1[0], yf[5] * rs * n1[1]); o.w = pk2(yf[6] * rs * n1[2], yf[7] * rs * n1[3]);
              *(u32x4*)(YC + (size_t)grow * 2048 + ch) = o; } }
    __syncthreads();
}

__device__ __forceinline__ void gmlp_phase(const Params& p, unsigned char* smem) {
    const int tid = opaque_tid(), wave = tid >> 6, lane = tid & 63, fr = lane & 15, fq = lane >> 4;
    const int g = blockIdx.x & 15, cstep = gridDim.x >> 4;
    const bf16_t* P = (const bf16_t*)(p.ws + OFF_P); bf16_t* YC = (bf16_t*)(p.ws + OFF_YC); const float* LNP = (const float*)(p.ws + OFF_DT);
    bf16_t* Ws = (bf16_t*)smem; bf16_t* VT = Ws + 128 * LDP; float* stat = (float*)(smem + 69632);
    { const float* wsrc = p.in[29] + (size_t)g * 16384;
#pragma unroll
      for (int it = 0; it < 4; ++it) { const int bb = tid + 512 * it, row = bb >> 4, c8 = (bb & 15) * 8; const f32x4 a = *(const f32x4*)(wsrc + row * 128 + c8), c = *(const f32x4*)(wsrc + row * 128 + c8 + 4);
          u32x4 o; o.x = pk2(a[0], a[1]); o.y = pk2(a[2], a[3]); o.z = pk2(c[0], c[1]); o.w = pk2(c[2], c[3]); *(u32x4*)(Ws + row * LDP + c8) = o; } }
    const int d0 = (tid & 15) * 8, vj0 = (tid >> 4) * 4, vch = g * 128 + d0;
    const f32x4 ga = *(const f32x4*)(p.in[27] + vch), gb = *(const f32x4*)(p.in[27] + vch + 4), ba = *(const f32x4*)(p.in[28] + vch), bb = *(const f32x4*)(p.in[28] + vch + 4);
    const float gg[8] = {ga[0], ga[1], ga[2], ga[3], gb[0], gb[1], gb[2], gb[3]}, be[8] = {ba[0], ba[1], ba[2], ba[3], bb[0], bb[1], bb[2], bb[3]};
    const int i = wave * 16 + fr;
    const float bsi = p.in[30][g * 128 + i];
    f32x4 st[4]; u32x4 vr[4];
#define GM_LOAD(CG) do { const int r0_ = (CG) * 128; const float* lp = LNP + ((size_t)(r0_ + (tid >> 2)) * 32 + (tid & 3) * 8) * 2; \
        _Pragma("unroll") for (int k = 0; k < 4; ++k) st[k] = *(const f32x4*)(lp + 4 * k); \
        _Pragma("unroll") for (int jj = 0; jj < 4; ++jj) vr[jj] = *(const u32x4*)(P + (size_t)(r0_ + vj0 + jj) * 6144 + 2048 + vch); } while (0)
    if ((int)(blockIdx.x >> 4) < 96) GM_LOAD(blockIdx.x >> 4);
#pragma unroll 1
    for (int cgi = blockIdx.x >> 4; cgi < 96; cgi += cstep) {
        const int row0 = cgi * 128; const size_t grow = (size_t)(row0 + i);
        u32x4 uu[4], gt[4];
#pragma unroll
        for (int t = 0; t < 4; ++t) { const int ch = g * 128 + t * 32 + 8 * fq; uu[t] = *(const u32x4*)(P + grow * 6144 + ch); gt[t] = *(const u32x4*)(P + grow * 6144 + 4096 + ch); }
        { float s1 = st[0][0] + st[0][2] + st[1][0] + st[1][2] + st[2][0] + st[2][2] + st[3][0] + st[3][2], s2 = st[0][1] + st[0][3] + st[1][1] + st[1][3] + st[2][1] + st[2][3] + st[3][1] + st[3][3];
          s1 += __shfl_xor(s1, 1); s2 += __shfl_xor(s2, 1); s1 += __shfl_xor(s1, 2); s2 += __shfl_xor(s2, 2);
          const float mean = s1 * (1.f / 2048.f), var = fmaxf(s2 * (1.f / 2048.f) - mean * mean, 0.f);
          if ((tid & 3) == 0) { stat[(tid >> 2) * 2] = mean; stat[(tid >> 2) * 2 + 1] = rsqrtf(var + 1e-5f); } }
        __syncthreads();
        { float vn[4][8];
#pragma unroll
          for (int jj = 0; jj < 4; ++jj) { float x[8]; unpack8(vr[jj], x); const float mean = stat[(vj0 + jj) * 2], rstd = stat[(vj0 + jj) * 2 + 1];
#pragma unroll
              for (int e = 0; e < 8; ++e) vn[jj][e] = (x[e] - mean) * rstd * gg[e] + be[e]; }
#pragma unroll
          for (int e = 0; e < 8; ++e) { u32x2 o; o.x = pk2(vn[0][e], vn[1][e]); o.y = pk2(vn[2][e], vn[3][e]);
              const int rho = (d0 & ~31) + 16 * (e >> 2) + ((d0 & 31) >> 1) + (e & 3);
              *(u32x2*)(VT + swz(rho, vj0)) = o; } }
        __syncthreads();
        if (cgi + cstep < 96) GM_LOAD(cgi + cstep);
        f32x4 acc[8];
#pragma unroll
        for (int nt = 0; nt < 8; ++nt) acc[nt] = (f32x4){0.f, 0.f, 0.f, 0.f};
#pragma unroll
        for (int ks = 0; ks < 4; ++ks) { const bf16x8 a = *(const bf16x8*)(Ws + i * LDP + ks * 32 + fq * 8);
#pragma unroll
            for (int nt = 0; nt < 8; ++nt) acc[nt] = mfma16(*(const bf16x8*)(VT + swz(nt * 16 + fr, ks * 32 + fq * 8)), a, acc[nt]); }
#pragma unroll
        for (int t = 0; t < 4; ++t) { const int ch = g * 128 + t * 32 + 8 * fq; float uf[8], gf[8]; unpack8(uu[t], uf); unpack8(gt[t], gf);
            const f32x4 a0 = acc[2 * t], a1 = acc[2 * t + 1];
            u32x4 o; o.x = pk2(uf[0] * (a0[0] + bsi) * gf[0], uf[1] * (a0[1] + bsi) * gf[1]); o.y = pk2(uf[2] * (a0[2] + bsi) * gf[2], uf[3] * (a0[3] + bsi) * gf[3]);
            o.z = pk2(uf[4] * (a1[0] + bsi) * gf[4], uf[5] * (a1[1] + bsi) * gf[5]); o.w = pk2(uf[6] * (a1[2] + bsi) * gf[6], uf[7] * (a1[3] + bsi) * gf[7]);
            *(u32x4*)(YC + grow * 2048 + ch) = o; }
        __syncthreads();
    }
}

__device__ __forceinline__ void ln_phase(const Params& p, int layer) {
    const int tid = opaque_tid(), wave = tid >> 6, lane = tid & 63;
    const float* G = p.in[layer ? 32 : 22]; const float* B = p.in[layer ? 33 : 23];
    const float* MODS = (const float*)(p.ws + OFF_MODS) + 9 * 3072; bf16_t* H = (bf16_t*)(p.ws + OFF_H);
    const bf16_t* Yg = (const bf16_t*)(p.ws + OFF_P); const float* POSR = (const float*)(p.ws + OFF_POSR); const float* POSC = (const float*)(p.ws + OFF_POSC);
    for (int rb = (blockIdx.x * 8 + wave) * 3; rb < NTOK; rb += gridDim.x * 24) {
        f32x4 v[3][4]; u32x2 yv[3][4]; f32x4 pe[3][4];
#pragma unroll
        for (int k = 0; k < 3; ++k) { const int r = rb + k;
            const float* xr = layer ? p.out + (size_t)r * 1024 : (r < 4096 ? p.in[0] + (size_t)r * 1024 : p.in[1] + (size_t)(r - 4096) * 1024);
            const int l = (r - 4096) & 1023;
#pragma unroll
            for (int i = 0; i < 4; ++i) { const int c = lane * 4 + 256 * i; v[k][i] = *(const f32x4*)(xr + c); yv[k][i] = *(const u32x2*)(Yg + (size_t)r * 1024 + c);
                pe[k][i] = (f32x4){0.f, 0.f, 0.f, 0.f};
                if (layer == 0 && r >= 4096) pe[k][i] = *(const f32x4*)(c < 512 ? POSR + (l >> 6) * 512 + c : POSC + (l & 63) * 512 + (c - 512)); } }
#pragma unroll
        for (int k = 0; k < 3; ++k) { const int r = rb + k; float s = 0.f;
#pragma unroll
            for (int i = 0; i < 4; ++i) { const f32x4 y = (f32x4){bflo(yv[k][i].x), bfhi(yv[k][i].x), bflo(yv[k][i].y), bfhi(yv[k][i].y)};
                v[k][i] = (v[k][i] + pe[k][i]) * ALPHA_C + y; s += v[k][i][0] + v[k][i][1] + v[k][i][2] + v[k][i][3]; }
#pragma unroll
            for (int o = 1; o < 64; o <<= 1) s += __shfl_xor(s, o);
            const float mean = s * (1.f / 1024.f); float q = 0.f;
#pragma unroll
            for (int i = 0; i < 4; ++i) { v[k][i] -= mean; q += v[k][i][0] * v[k][i][0] + v[k][i][1] * v[k][i][1] + v[k][i][2] * v[k][i][2] + v[k][i][3] * v[k][i][3]; }
#pragma unroll
            for (int o = 1; o < 64; o <<= 1) q += __shfl_xor(q, o);
            const float rstd = rsqrtf(q * (1.f / 1024.f) + 1e-5f);
            const int cond = cond_of_row(r); float* xo = p.out + (size_t)r * 1024;
#pragma unroll
            for (int i = 0; i < 4; ++i) { const int c = lane * 4 + 256 * i; const f32x4 y = v[k][i] * rstd * *(const f32x4*)(G + c) + *(const f32x4*)(B + c);
                *(f32x4*)(xo + c) = y;
                if (layer == 0) { const f32x4 sh = *(const f32x4*)(MODS + cond * 3072 + c), sc = *(const f32x4*)(MODS + cond * 3072 + 1024 + c); const f32x4 h = y * (sc + 1.0f) + sh;
                    u32x2 o; o.x = pk2(h[0], h[1]); o.y = pk2(h[2], h[3]); *(u32x2*)(H + (size_t)r * 1024 + c) = o; } } }
    }
}

constexpr int NPHASE = 11;
template <int PH> __device__ __forceinline__ void run_phase(const Params& p, unsigned char* shm) {
    const bf16_t* H = (const bf16_t*)(p.ws + OFF_H); bf16_t* Pb = (bf16_t*)(p.ws + OFF_P); const bf16_t* YC = (const bf16_t*)(p.ws + OFF_YC);
    const float* MODS = (const float*)(p.ws + OFF_MODS);
    if constexpr (PH == 0) phase_prep(p, shm);
    if constexpr (PH == 1) phase_conv_h0(p, shm);
    if constexpr (PH == 2 || PH == 7) {
        pg8::Gemm g; g.A = H; g.Bt = (const bf16_t*)(p.ws + (PH == 2 ? OFF_WT0 : OFF_WT1)); g.M = NTOK; g.N = PH == 2 ? 6400 : 6144; g.K = 1024;
        pg8::StaticOrder S; S.init(g.M, g.N, (int)gridDim.x, (int)blockIdx.x);
        EpiIn E; E.P = Pb; E.DT = (float*)(p.ws + OFF_DT); E.LNP = PH == 2 ? nullptr : (float*)(p.ws + OFF_DT);
        pg8::gemm_phase<EpiIn, pg8::StaticOrder, false>((PG8_LAS unsigned char*)shm, g, S, E, nullptr);
    }
    if constexpr (PH == 3 || PH == 4) {
        const bool bal = gridDim.x == 256;
#ifndef DUP_YUNIT
#define DUP_YUNIT 0
#endif
        for (int u = blockIdx.x; u < 384; u += gridDim.x) { if (PH == 3) sstate_unit(p, shm, u); else { for (int rep_ = 0; rep_ <= DUP_YUNIT; ++rep_) ssd_y_unit(p, shm, u); } }
#ifndef CONF_P3
#define CONF_P3 3
#endif
        if (bal) { if (blockIdx.x >= 128) { const int c0 = ((int)blockIdx.x - 128) * 6 + (PH == 3 ? 0 : CONF_P3); const int nk = PH == 3 ? CONF_P3 : 6 - CONF_P3; for (int k = 0; k < nk; ++k) conformer_unit(p, shm, c0 + k); } }
        else if (PH == 3) { for (int u = gridDim.x - 1 - blockIdx.x; u < 768; u += gridDim.x) conformer_unit(p, shm, u); }
    }
    if constexpr (PH == 5 || PH == 9) {
        pg8::Gemm g; g.A = YC; g.Bt = (const bf16_t*)(p.ws + (PH == 5 ? OFF_WO0 : OFF_WO1)); g.M = NTOK; g.N = 1024; g.K = 2048;
        pg8::StaticOrder S; S.init(g.M, g.N, (int)gridDim.x, (int)blockIdx.x);
        EpiOut E; E.Y = (bf16_t*)(p.ws + OFF_P); E.gate = MODS + (PH == 5 ? 0 : 9 * 3072) + 2048;
        pg8::gemm_phase<EpiOut, pg8::StaticOrder, false>((PG8_LAS unsigned char*)shm, g, S, E, nullptr);
        if (PH == 5 && gridDim.x == 256 && blockIdx.x >= 192) {
            transpose_tiles<2>(p.in[26], (bf16_t*)(p.ws + OFF_WT1), (float*)shm, (int)blockIdx.x - 192, 64);
            transpose_tiles<3>(p.in[31], (bf16_t*)(p.ws + OFF_WO1), (float*)shm, (int)blockIdx.x - 192, 64); }
    }
    if constexpr (PH == 6) ln_phase(p, 0);
    if constexpr (PH == 8) gmlp_phase(p, shm);
    if constexpr (PH == 10) ln_phase(p, 1);
    if constexpr (PH == 11) prefix_phase(p);
}

#ifndef MULTI_LAUNCH
__global__ __launch_bounds__(512, 2) void mega_kernel(Params p) {
    extern __shared__ __attribute__((aligned(16))) unsigned char shm[];
    cg::grid_group grid = cg::this_grid();
    if (p.ws == nullptr) grid.sync();
    volatile LAS unsigned* st = (volatile LAS unsigned*)((LAS unsigned char*)shm + 163824);
    if (threadIdx.x == 0) { st[0] = 0u; st[1] = 0u; st[2] = 0u; st[3] = 0u; }
    __syncthreads();
    const XcdBarrier xb = xcd_barrier_post((unsigned*)(p.ws + OFF_BAR), st);
#ifndef REP_MASK
#define REP_MASK 0
#endif
#define GSYNC() xcd_barrier(xb)
#define RUNP(k) run_phase<k>(p, shm); GSYNC(); if (REP_MASK & (1 << k)) { run_phase<k>(p, shm); GSYNC(); }
    RUNP(0) RUNP(1) RUNP(2) RUNP(3)
    run_phase<11>(p, shm); GSYNC();
    RUNP(4) RUNP(5)
    RUNP(6)
    RUNP(7) RUNP(8)
    run_phase<9>(p, shm); GSYNC();
    run_phase<10>(p, shm);
}
#else
template <int PH> __global__ __launch_bounds__(512, 2) void phase_kernel(Params p) {
    extern __shared__ __attribute__((aligned(16))) unsigned char shm[];
    run_phase<PH>(p, shm);
}
template <int PH> static void launch_phase(const Params& p, hipStream_t stream) {
    hipFuncSetAttribute((const void*)phase_kernel<PH>, hipFuncAttributeMaxDynamicSharedMemorySize, 163840);
    phase_kernel<PH><<<256, 512, 163840, stream>>>(p);
}
#endif

extern "C" void kernel_launch(void* const* d_in, const int* in_sizes, int n_in, void* d_out, int out_size, void* d_ws, size_t ws_size, hipStream_t stream) {
    Params p{};
    for (int i = 0; i < 34; ++i) p.in[i] = (const float*)d_in[i];
    p.out = (float*)d_out; p.ws = (unsigned char*)d_ws;
    constexpr size_t kDynLds = 163840;
#ifndef MULTI_LAUNCH
    static int grid_blocks = 0;
    if (!grid_blocks) {
        int dev = 0, cus = 0, per_cu = 0;
        hipGetDevice(&dev);
        hipDeviceGetAttribute(&cus, hipDeviceAttributeMultiprocessorCount, dev);
        hipFuncSetAttribute((const void*)mega_kernel, hipFuncAttributeMaxDynamicSharedMemorySize, (int)kDynLds);
        hipOccupancyMaxActiveBlocksPerMultiprocessor(&per_cu, mega_kernel, 512, kDynLds);
        if (per_cu < 1) per_cu = 1;
        grid_blocks = cus * (per_cu > 1 ? 1 : per_cu);
    }
    hipMemsetAsync((unsigned char*)d_ws + OFF_BAR, 0, XCD_BAR_WORDS * sizeof(unsigned), stream);
    void* args[] = {&p};
    hipError_t e = hipLaunchCooperativeKernel((void*)mega_kernel, dim3(grid_blocks), dim3(512), args, kDynLds, stream);
    if (e != hipSuccess) fprintf(stderr, "cooperative launch failed: %s (grid %d)\n", hipGetErrorString(e), grid_blocks);
#else
    launch_phase<0>(p, stream); launch_phase<1>(p, stream); launch_phase<2>(p, stream); launch_phase<3>(p, stream); launch_phase<11>(p, stream); launch_phase<4>(p, stream); launch_phase<5>(p, stream);
    launch_phase<6>(p, stream); launch_phase<7>(p, stream); launch_phase<8>(p, stream); launch_phase<9>(p, stream); launch_phase<10>(p, stream);
#endif
}
```

```cpp
#include <hip/hip_runtime.h>
#include <hip/hip_cooperative_groups.h>
#include <cstdio>
namespace cg = cooperative_groups;
namespace pg8 {
#define PG8_LAS __attribute__((address_space(3)))
typedef unsigned short bf16_t;
typedef short bf16x8 __attribute__((ext_vector_type(8)));
typedef float f32x4 __attribute__((ext_vector_type(4)));
typedef unsigned u32x4 __attribute__((ext_vector_type(4)));
constexpr int BM = 256, BK = 64, HALF = 128, HTB = HALF * BK * 2  , STAGE_BYTES = 8 * HTB, NXCD = 8, WGM = 8;

__host__ __device__ __forceinline__ int lds_byte(int r, int c) { const int st = (r >> 4) * 2 + (c >> 5), rr = r & 15, cc = c & 31, ob = rr * 64 + cc * 2; return st * 1024 + (ob ^ (((ob >> 9) & 1) << 5)); }
__host__ __device__ __forceinline__ void stage_rc(int b, int& R, int& C) { const int st = b / 1024, sb = b % 1024, swz = sb ^ (((sb >> 9) & 1) << 5); R = (st >> 1) * 16 + swz / 64; C = (st & 1) * 32 + (swz % 64) / 2; }
__host__ __device__ __forceinline__ int perm32(int rho) { const int n = rho >> 4, i = rho & 15; return 8 * (i >> 2) + 4 * n + (i & 3); }

struct Unit { int pm, pn; };
struct Gemm { const bf16_t* A; const bf16_t* Bt; int M, N, K; };

struct StaticOrder {
    int nM, nN, nwg, G, c;
    __host__ __device__ void init(int M, int N, int G_, int c_) { nM = M / BM; nN = N / BM; nwg = nM * nN; G = G_; c = c_; }
    __host__ __device__ bool next(int i, Unit& u) const {
        const long L = (long)i * G + c; if (L >= nwg) return false;
        int wgid = (int)L; { const int q = nwg / NXCD, r = nwg % NXCD, xcd = wgid % NXCD, off = wgid / NXCD; wgid = (xcd < r ? xcd * (q + 1) : r * (q + 1) + (xcd - r) * q) + off; }
        const int nig = WGM * nN, gid = wgid / nig, fm = gid * WGM, gsz = (nM - fm) < WGM ? (nM - fm) : WGM;
        u.pm = fm + ((wgid % nig) % gsz); u.pn = (wgid % nig) / gsz; return true;
    }
    __device__ __forceinline__ void a_ready(const Unit&) const {}
    __device__ __forceinline__ void done(const Unit&) const {}
};
typedef __bf16 bf16x2n_t __attribute__((ext_vector_type(2))); typedef float f32x2n_t __attribute__((ext_vector_type(2)));
__device__ __forceinline__ unsigned cvt_pk_bf16(float lo, float hi) { f32x2n_t v = {lo, hi}; bf16x2n_t r = __builtin_convertvector(v, bf16x2n_t); return __builtin_bit_cast(unsigned, r); }
template <class Epi, class Sched, bool STAMP = false>
__device__ __forceinline__ void gemm_phase(PG8_LAS unsigned char* lds, const Gemm g, const Sched& S, const Epi& E, unsigned long long* stamps) {
    int tid_ = threadIdx.x; asm volatile("" : "+v"(tid_));
    const int tid = tid_, wid = __builtin_amdgcn_readfirstlane(tid >> 6), lane = tid & 63, wr = wid >> 2, wc = wid & 3, fr = lane & 15, fq = lane >> 4;
    const int K = g.K, nt = K / BK;
    int ts_lo = 0, ts_hi = 0, nts = 0; const unsigned long long rt_entry = STAMP ? (unsigned long long)wall_clock64() : 0ull;
#define PG8_STAMP() do { if (STAMP && wid == 0 && nts < 64) { const unsigned long long _c = (unsigned long long)clock64(); \
        ts_lo = (lane == nts) ? (int)(unsigned)_c : ts_lo; ts_hi = (lane == nts) ? (int)(unsigned)(_c >> 32) : ts_hi; ++nts; } } while (0)
    PG8_STAMP();
    unsigned voffA[2], voffB[2];
#pragma unroll
    for (int i = 0; i < 2; ++i) { int R, C; stage_rc(tid * 16 + i * 8192, R, C); const int Rb = Epi::PERM ? ((R & ~31) + perm32(R & 31)) : R;
        voffA[i] = (unsigned)(R * K + C) * 2u; voffB[i] = (unsigned)(Rb * K + C) * 2u; }
    const size_t kstep = (size_t)(BK * 2);
    const size_t hstep = (size_t)HALF * K * 2;
    const size_t tstep = 2 * hstep;
    const unsigned ldsw = (unsigned)wid * 1024u;
    const int aoff = lds_byte(wr * 64 + fr, fq * 8), boff = lds_byte(wc * 32 + fr, fq * 8);
#define PG8_SA(b, h) (((b) * 2 + (h)) * HTB)
#define PG8_SB(b, h) ((4 + (b) * 2 + (h)) * HTB)
#define PG8_STAGE(bufoff, gbase, voff) do { _Pragma("unroll") for (int _i = 0; _i < 2; ++_i) \
        __builtin_amdgcn_global_load_lds((const unsigned*)((const char*)(gbase) + (voff)[_i]), (PG8_LAS unsigned*)(lds + (bufoff) + ldsw + _i * 8192), 16, 0, 0); } while (0)
#define PG8_LDA(dst, b, h) do { _Pragma("unroll") for (int m = 0; m < 4; ++m) _Pragma("unroll") for (int k = 0; k < 2; ++k) dst[m][k] = *(const PG8_LAS bf16x8*)(lds + PG8_SA(b, h) + aoff + m * 2048 + k * 1024); } while (0)
#define PG8_LDB(dst, b, h) do { _Pragma("unroll") for (int n = 0; n < 2; ++n) _Pragma("unroll") for (int k = 0; k < 2; ++k) dst[n][k] = *(const PG8_LAS bf16x8*)(lds + PG8_SB(b, h) + boff + n * 2048 + k * 1024); } while (0)
#define PG8_MMA(ai, bj, At, Bt) do { __builtin_amdgcn_s_setprio(1); _Pragma("unroll") for (int m = 0; m < 4; ++m) _Pragma("unroll") for (int n = 0; n < 2; ++n) _Pragma("unroll") for (int k = 0; k < 2; ++k) \
        acc[ai][bj][m][n] = __builtin_amdgcn_mfma_f32_16x16x32_bf16(Bt[n][k], At[m][k], acc[ai][bj][m][n], 0, 0, 0); __builtin_amdgcn_s_setprio(0); } while (0)
#define PG8_WAIT_V(n) asm volatile("s_waitcnt vmcnt(" #n ")" ::: "memory")
#define PG8_WAIT_L(n) asm volatile("s_waitcnt lgkmcnt(" #n ")" ::: "memory")
#define PG8_BAR __builtin_amdgcn_s_barrier()
#define PG8_SCHED __builtin_amdgcn_sched_barrier(0)
    Unit cur, nxt; int ui = 0;
    if (!S.next(0, cur)) return;
    f32x4 acc[2][2][4][2];
#pragma unroll
    for (int a = 0; a < 2; ++a)
#pragma unroll
        for (int b = 0; b < 2; ++b)
#pragma unroll
            for (int m = 0; m < 4; ++m)
#pragma unroll
                for (int n = 0; n < 2; ++n) acc[a][b][m][n] = (f32x4){0.f, 0.f, 0.f, 0.f};
    bf16x8 At[4][2], B0[2][2], B1[2][2];
    const char* cA = (const char*)g.A + (size_t)cur.pm * tstep; const char* cB = (const char*)g.Bt + (size_t)cur.pn * tstep;
    S.a_ready(cur);
    PG8_STAGE(PG8_SB(0, 0), cB, voffB); PG8_STAGE(PG8_SA(0, 0), cA, voffA); PG8_STAGE(PG8_SB(0, 1), cB + hstep, voffB); PG8_STAGE(PG8_SA(0, 1), cA + hstep, voffA);
    if (wr == 1) PG8_BAR;
    PG8_WAIT_V(4); PG8_BAR;
    PG8_STAGE(PG8_SB(1, 0), cB + kstep, voffB); PG8_STAGE(PG8_SA(1, 0), cA + kstep, voffA); PG8_STAGE(PG8_SB(1, 1), cB + hstep + kstep, voffB);
    PG8_WAIT_V(6); PG8_BAR;
    PG8_STAMP();
    for (;;) {
        const bool has_next = S.next(ui + 1, nxt);
        const char* nA = has_next ? (const char*)g.A + (size_t)nxt.pm * tstep : cA; const char* nB = has_next ? (const char*)g.Bt + (size_t)nxt.pn * tstep : cB;
        for (int t = 0; t < nt; t += 2) {
            const bool last = (t == nt - 2);
            const char* a1 = cA + (size_t)(t + 1) * kstep;
            const char* a2 = last ? nA : cA + (size_t)(t + 2) * kstep; const char* b2 = last ? nB : cB + (size_t)(t + 2) * kstep;
            const char* a3 = a2 + kstep; const char* b3 = b2 + kstep;
            if (last && has_next) S.a_ready(nxt);
            PG8_LDB(B0, 0, 0); PG8_SCHED; PG8_LDA(At, 0, 0); PG8_STAGE(PG8_SA(1, 1), a1 + hstep, voffA);
            PG8_WAIT_L(8); PG8_BAR; PG8_WAIT_L(0); PG8_MMA(0, 0, At, B0); PG8_BAR; PG8_SCHED;
            PG8_LDB(B1, 0, 1); PG8_STAGE(PG8_SB(0, 0), b2, voffB);
            PG8_BAR; PG8_WAIT_L(0); PG8_MMA(0, 1, At, B1); PG8_BAR;
            PG8_LDA(At, 0, 1); PG8_STAGE(PG8_SA(0, 0), a2, voffA);
            PG8_BAR; PG8_WAIT_L(0); PG8_MMA(1, 0, At, B0); PG8_BAR; PG8_SCHED;
            PG8_STAGE(PG8_SB(0, 1), b2 + hstep, voffB);
            PG8_WAIT_V(6); PG8_BAR; PG8_MMA(1, 1, At, B1); PG8_BAR;
            PG8_LDB(B0, 1, 0); PG8_SCHED; PG8_LDA(At, 1, 0); PG8_STAGE(PG8_SA(0, 1), a2 + hstep, voffA);
            PG8_WAIT_L(8); PG8_BAR; PG8_WAIT_L(0); PG8_MMA(0, 0, At, B0); PG8_BAR; PG8_SCHED;
            PG8_LDB(B1, 1, 1); PG8_STAGE(PG8_SB(1, 0), b3, voffB);
            PG8_BAR; PG8_WAIT_L(0); PG8_MMA(0, 1, At, B1); PG8_BAR;
            PG8_LDA(At, 1, 1); PG8_STAGE(PG8_SA(1, 0), a3, voffA);
            PG8_BAR; PG8_WAIT_L(0); PG8_MMA(1, 0, At, B0); PG8_BAR; PG8_SCHED;
            PG8_STAGE(PG8_SB(1, 1), b3 + hstep, voffB);
            PG8_WAIT_V(6); PG8_BAR; PG8_MMA(1, 1, At, B1); PG8_BAR;
        }
        PG8_STAMP();
        if constexpr (!Epi::AFTER_DRAIN) { E(acc, cur, wr, wc, fr, fq); S.done(cur); }
        PG8_STAMP();
        if (!has_next) break;
#pragma unroll
        for (int a = 0; a < 2; ++a)
#pragma unroll
            for (int b = 0; b < 2; ++b)
#pragma unroll
                for (int m = 0; m < 4; ++m)
#pragma unroll
                    for (int n = 0; n < 2; ++n) acc[a][b][m][n] = (f32x4){0.f, 0.f, 0.f, 0.f};
        cur = nxt; cA = nA; cB = nB; ++ui;
    }
    PG8_WAIT_V(0);
    if (wr == 0) PG8_BAR;
    PG8_BAR;
    if constexpr (Epi::AFTER_DRAIN) { E.fused(acc, cur, wr, wc, fr, fq, lds, wid, lane); S.done(cur); }
    PG8_STAMP();
    if (STAMP && wid == 0) { stamps[lane] = lane < nts ? (((unsigned long long)(unsigned)ts_hi << 32) | (unsigned)ts_lo) : 0ull;
        if (lane == 62) stamps[62] = rt_entry; if (lane == 63) stamps[63] = (unsigned long long)wall_clock64(); }
#undef PG8_STAMP
#undef PG8_SA
#undef PG8_SB
#undef PG8_STAGE
#undef PG8_LDA
#undef PG8_LDB
#undef PG8_MMA
#undef PG8_WAIT_V
#undef PG8_WAIT_L
#undef PG8_BAR
#undef PG8_SCHED
}
}
#define XB_TMO      128
#define XB_XCNT(j)  (256  + 64 * (j))
#define XB_XSUB(j)  (1280 + 64 * (j))
#define XB_XGEN(j)  (2304 + 64 * (j))
#define XB_TOP      3328
#define XB_TOPGEN   3392
#define XCD_BAR_WORDS 3456
#define XB_SPIN_CAP (1u << 18)
#define LAS __attribute__((address_space(3)))

__device__ __forceinline__ unsigned xb_ld(unsigned* p)              { return __hip_atomic_load(p, __ATOMIC_RELAXED, __HIP_MEMORY_SCOPE_AGENT); }
__device__ __forceinline__ unsigned xb_add(unsigned* p, unsigned v) { return __hip_atomic_fetch_add(p, v, __ATOMIC_RELAXED, __HIP_MEMORY_SCOPE_AGENT); }
__device__ __forceinline__ unsigned xb_xcc_id() { return (unsigned)__builtin_amdgcn_s_getreg((3 << 11) | 20) & 0xFu; }
#define XB_SPIN(cond, bar) do { unsigned _sp = 0; while (cond) { __builtin_amdgcn_s_sleep(1); \
    if ((++_sp & 255u) == 0u) { if (xb_ld(&(bar)[XB_TMO])) break; if (_sp > XB_SPIN_CAP) { atomicAdd(&(bar)[XB_TMO], 1u); break; } } } } while (0)

struct XcdBarrier {
    unsigned* bar; unsigned x;
    volatile LAS unsigned* st;
};

__device__ __forceinline__ XcdBarrier xcd_barrier_post(unsigned* bar, volatile LAS unsigned* st) {
    XcdBarrier b; b.bar = bar; b.x = xb_xcc_id(); b.st = st;
    if (threadIdx.x == 0) (void)xb_add(&bar[XB_XCNT(b.x)], 1u);
    return b;
}
__device__ __forceinline__ void xcd_barrier_complete(unsigned* bar, unsigned x, unsigned& nloc, unsigned& nx) {
    const unsigned G = gridDim.x * gridDim.y * gridDim.z;
    unsigned sum, cnt, mine, sp = 0u;
    for (;;) {
        sum = 0u; cnt = 0u; mine = 0u;
#pragma unroll
        for (unsigned j = 0; j < 16; ++j) { const unsigned c = xb_ld(&bar[XB_XCNT(j)]); sum += c; cnt += (c > 0u) ? 1u : 0u; mine = (j == x) ? c : mine; }
        if (sum == G) break;
        __builtin_amdgcn_s_sleep(1);
        if ((++sp & 255u) == 0u) { if (xb_ld(&bar[XB_TMO])) break; if (sp > XB_SPIN_CAP) { atomicAdd(&bar[XB_TMO], 1u); break; } }
    }
    nloc = mine > 0u ? mine : 1u; nx = cnt > 0u ? cnt : 1u;
}

__device__ __forceinline__ void xcd_barrier(const XcdBarrier& b) {
    asm volatile("s_waitcnt vmcnt(0)" ::: "memory");
    __syncthreads();
    if (threadIdx.x == 0) {
        unsigned* bar = b.bar;
        __builtin_amdgcn_s_waitcnt(0);
        unsigned nloc = b.st[0], nx = b.st[1];
        if (nloc == 0u) { xcd_barrier_complete(bar, b.x, nloc, nx); b.st[0] = nloc; b.st[1] = nx; }
        const unsigned old = xb_add(&bar[XB_XSUB(b.x)], 1u);
        const unsigned gen = old / nloc;
        if (old + 1u == (gen + 1u) * nloc) {
            __builtin_amdgcn_fence(__ATOMIC_RELEASE, "agent");
            asm volatile("s_waitcnt vmcnt(0)" ::: "memory");
            const unsigned og = xb_add(&bar[XB_TOP], 1u);
            const unsigned tg = og / nx;
            if (og + 1u == (tg + 1u) * nx) xb_add(&bar[XB_TOPGEN], 1u);
            else XB_SPIN(xb_ld(&bar[XB_TOPGEN]) == tg, bar);
            __builtin_amdgcn_fence(__ATOMIC_ACQUIRE, "agent");
            xb_add(&bar[XB_XGEN(b.x)], 1u);
            asm volatile("s_waitcnt vmcnt(0)" ::: "memory");
        } else {
            XB_SPIN(xb_ld(&bar[XB_XGEN(b.x)]) == gen, bar);
            __builtin_amdgcn_fence(__ATOMIC_ACQUIRE, "agent");
            asm volatile("s_waitcnt vmcnt(0)" ::: "memory");
        }
    }
    __syncthreads();
}


using pg8::bf16x8; using pg8::f32x4; using pg8::u32x4;
typedef unsigned short bf16_t;
typedef unsigned u32x2 __attribute__((ext_vector_type(2)));
typedef float f32x2v __attribute__((ext_vector_type(2)));

struct Params { const float* in[34]; float* out; unsigned char* ws; };

constexpr int NTOK = 12288;
constexpr size_t OFF_WT0 = 0, OFF_WO0 = 13107200, OFF_WT1 = 17301504, OFF_WO1 = 29884416, OFF_H = 34078720, OFF_P = 59244544,
                 OFF_YC = 210239488, OFF_DT = 260571136, OFF_MODS = 263716864, OFF_POSR = 263938048, OFF_POSC = 263970816, OFF_DEC = 264101888, OFF_BAR = 264114176;
constexpr size_t OUT_STF = 12582912, OUT_STB = 14680064;
constexpr float ALPHA_C = 1.41421356237f;
constexpr int LDP = 136;

__device__ __forceinline__ float bf2f(unsigned short b) { return __uint_as_float(((unsigned)b) << 16); }
__device__ __forceinline__ float bflo(unsigned u) { return __uint_as_float(u << 16); }
__device__ __forceinline__ float bfhi(unsigned u) { return __uint_as_float(u & 0xffff0000u); }
__device__ __forceinline__ unsigned pk2(float lo, float hi) { return pg8::cvt_pk_bf16(lo, hi); }
__device__ __forceinline__ float silu_f(float x) { return x * __builtin_amdgcn_rcpf(1.f + __expf(-x)); }
__device__ __forceinline__ float sigmoid_f(float x) { return __builtin_amdgcn_rcpf(1.f + __expf(-x)); }
__device__ __forceinline__ int swz(int r, int j) { return r * LDP + ((((j >> 3) ^ (r >> 3)) & 15) << 3) + (j & 7); }
__device__ __forceinline__ float softplus_f(float x) { return x > 20.f ? x : log1pf(expf(x)); }
__device__ __forceinline__ f32x4 mfma16(bf16x8 a, bf16x8 b, f32x4 c) { return __builtin_amdgcn_mfma_f32_16x16x32_bf16(a, b, c, 0, 0, 0); }
__device__ __forceinline__ void unpack8(u32x4 v, float (&o)[8]) { o[0] = bflo(v.x); o[1] = bfhi(v.x); o[2] = bflo(v.y); o[3] = bfhi(v.y); o[4] = bflo(v.z); o[5] = bfhi(v.z); o[6] = bflo(v.w); o[7] = bfhi(v.w); }
__device__ __forceinline__ int opaque_tid() { int t = threadIdx.x; asm volatile("" : "+v"(t)); return t; }
__device__ __forceinline__ int cond_of_row(int r) { return r < 4096 ? 0 : 1 + ((r - 4096) >> 10); }

template <int WHICH> __device__ __forceinline__ void tr_load(const float* __restrict__ src, int tt, int tid, f32x4 (&v)[4]) {
    constexpr int K = (WHICH == 0 || WHICH == 2) ? 1024 : 2048, Nsrc = WHICH == 0 ? 6176 : (WHICH == 2 ? 6144 : 1024), nkt = K / 64;
    const int ntile = tt / nkt, ktile = tt % nkt;
#pragma unroll
    for (int i = 0; i < 4; ++i) { const int idx = tid + 512 * i, k = idx >> 5, nd = ntile * 128 + (idx & 31) * 4; int ns = nd; bool ok = true;
        if (WHICH == 0) { if (nd < 3072) ns = nd; else if (nd < 5120) { const int t = (nd - 3072) >> 8, lc = (nd - 3072) & 255; ns = lc < 128 ? 3104 + 128 * t + lc : 4128 + 128 * t + (lc - 128); } else if (nd < 6144) ns = nd + 32; else if (nd < 6176) ns = nd - 3072; else { ok = false; ns = 0; } }
        const f32x4 x = *(const f32x4*)(src + (size_t)(ktile * 64 + k) * Nsrc + ns); v[i] = ok ? x : (f32x4){0.f, 0.f, 0.f, 0.f}; }
}
template <int WHICH> __device__ __forceinline__ void transpose_tiles(const float* __restrict__ src, bf16_t* __restrict__ dst, float* tile, int bidx, int nb) {
    constexpr int K = (WHICH == 0 || WHICH == 2) ? 1024 : 2048, Nsrc = WHICH == 0 ? 6176 : (WHICH == 2 ? 6144 : 1024), Ndst = WHICH == 0 ? 6400 : Nsrc;
    constexpr int nkt = K / 64, ntiles = (Ndst / 128) * nkt;
    const int tid = opaque_tid();
    f32x4 cur[4];
    if (bidx < ntiles) tr_load<WHICH>(src, bidx, tid, cur);
    for (int tt = bidx; tt < ntiles; tt += nb) {
        const int ntile = tt / nkt, ktile = tt % nkt;
#pragma unroll
        for (int i = 0; i < 4; ++i) { const int idx = tid + 512 * i; float* tp = tile + (idx >> 5) * 129 + (idx & 31) * 4; tp[0] = cur[i][0]; tp[1] = cur[i][1]; tp[2] = cur[i][2]; tp[3] = cur[i][3]; }
        __syncthreads();
        if (tt + nb < ntiles) tr_load<WHICH>(src, tt + nb, tid, cur);
#pragma unroll
        for (int i = 0; i < 2; ++i) { const int idx = tid + 512 * i, n = idx >> 3, k8 = (idx & 7) * 8;
          const float e0 = tile[(k8 + 0) * 129 + n], e1 = tile[(k8 + 1) * 129 + n], e2 = tile[(k8 + 2) * 129 + n], e3 = tile[(k8 + 3) * 129 + n];
          const float e4 = tile[(k8 + 4) * 129 + n], e5 = tile[(k8 + 5) * 129 + n], e6 = tile[(k8 + 6) * 129 + n], e7 = tile[(k8 + 7) * 129 + n];
          u32x4 o; o.x = pk2(e0, e1); o.y = pk2(e2, e3); o.z = pk2(e4, e5); o.w = pk2(e6, e7);
          *(u32x4*)(dst + (size_t)(ntile * 128 + n) * K + ktile * 64 + k8) = o; }
        __syncthreads();
    }
}
__device__ __forceinline__ void phase_prep(const Params& p, unsigned char* smem) {
    float* sc = (float*)smem;
    float* red = sc + 9 * 1024;
    float* MODS = (float*)(p.ws + OFF_MODS);
    const int tid = opaque_tid();
    bool filled = false;
    for (int u = blockIdx.x; u < 192; u += gridDim.x) {
        if (!filled) {
            for (int e = tid; e < 9 * 1024; e += 512) { const int j = e >> 10, k = e & 1023; const float v = (j == 0) ? p.in[5][k] : p.in[4][(j - 1) * 1024 + k]; sc[e] = silu_f(v); }
            __syncthreads(); filled = true;
        }
        const int layer = u / 96, cb = u % 96;
        const float* W = p.in[layer ? 24 : 6]; const float* bias = p.in[layer ? 25 : 7];
        const int col = cb * 32 + (tid & 31), kg = tid >> 5;
        float acc[9];
#pragma unroll
        for (int j = 0; j < 9; ++j) acc[j] = 0.f;
#pragma unroll 16
        for (int kk = 0; kk < 64; ++kk) { const int k = kg * 64 + kk; const float w = W[(size_t)k * 3072 + col];
#pragma unroll
            for (int j = 0; j < 9; ++j) acc[j] = fmaf(sc[j * 1024 + k], w, acc[j]); }
#pragma unroll
        for (int j = 0; j < 9; ++j) red[(kg * 9 + j) * 32 + (tid & 31)] = acc[j];
        __syncthreads();
        if (tid < 288) { const int j = tid >> 5, c = tid & 31; float s = 0.f;
#pragma unroll
            for (int k2 = 0; k2 < 16; ++k2) s += red[(k2 * 9 + j) * 32 + c];
            MODS[(layer * 9 + j) * 3072 + cb * 32 + c] = s + bias[cb * 32 + c]; }
        __syncthreads();
    }
    __syncthreads();
    { float* tile = (float*)smem;
      const int G = gridDim.x, b = blockIdx.x;
      transpose_tiles<0>(p.in[8], (bf16_t*)(p.ws + OFF_WT0), tile, b, G);
      transpose_tiles<1>(p.in[21], (bf16_t*)(p.ws + OFF_WO0), tile, b, G);
      if (G != 256) {
          transpose_tiles<2>(p.in[26], (bf16_t*)(p.ws + OFF_WT1), tile, b, G);
          transpose_tiles<3>(p.in[31], (bf16_t*)(p.ws + OFF_WO1), tile, b, G); } }
    float* POSR = (float*)(p.ws + OFF_POSR); float* POSC = (float*)(p.ws + OFF_POSC);
    for (int e = blockIdx.x * 512 + tid; e < 80 * 512; e += gridDim.x * 512) {
        const int pos = e >> 9, d = e & 511, i = d & 255;
        const float freq = exp2f(-(float)i * (13.287712379549449f / 256.f));
        const float arg = (float)(pos < 16 ? pos : pos - 16) * freq;
        const float v = d < 256 ? sinf(arg) : cosf(arg);
        if (pos < 16) POSR[pos * 512 + d] = v; else POSC[(pos - 16) * 512 + d] = v;
    }
}

__device__ __forceinline__ void phase_conv_h0(const Params& p, unsigned char* smem) {
    const int tid = opaque_tid();
    const float* MODS = (const float*)(p.ws + OFF_MODS); const float* POSR = (const float*)(p.ws + OFF_POSR); const float* POSC = (const float*)(p.ws + OFF_POSC);
    bf16_t* H = (bf16_t*)(p.ws + OFF_H);
    const int wave = tid >> 6, lane = tid & 63;
    for (int rb = (blockIdx.x * 8 + wave) * 3; rb < NTOK; rb += gridDim.x * 24) {
        f32x4 xv[3][4], pe[3][4];
#pragma unroll
        for (int k = 0; k < 3; ++k) { const int r = rb + k; const float* xr = r < 4096 ? p.in[0] + (size_t)r * 1024 : p.in[1] + (size_t)(r - 4096) * 1024; const int l = (r - 4096) & 1023;
#pragma unroll
            for (int i = 0; i < 4; ++i) { const int c = lane * 4 + 256 * i; xv[k][i] = *(const f32x4*)(xr + c); pe[k][i] = (f32x4){0.f, 0.f, 0.f, 0.f};
                if (r >= 4096) pe[k][i] = *(const f32x4*)(c < 512 ? POSR + (l >> 6) * 512 + c : POSC + (l & 63) * 512 + (c - 512)); } }
#pragma unroll
        for (int k = 0; k < 3; ++k) { const int r = rb + k; const int cond = cond_of_row(r); const float* shift = MODS + cond * 3072; const float* scale = shift + 1024;
#pragma unroll
            for (int i = 0; i < 4; ++i) { const int c = lane * 4 + 256 * i; const f32x4 sc = *(const f32x4*)(scale + c), sh = *(const f32x4*)(shift + c);
                const f32x4 h = (xv[k][i] + pe[k][i]) * (sc + 1.0f) + sh;
                u32x2 o; o.x = pk2(h[0], h[1]); o.y = pk2(h[2], h[3]); *(u32x2*)(H + (size_t)r * 1024 + c) = o; } }
    }
}

struct EpiIn {
    static constexpr bool PERM = true, AFTER_DRAIN = false;
    bf16_t* P; float* DT; float* LNP;
    __device__ __forceinline__ void operator()(const f32x4 (&acc)[2][2][4][2], const pg8::Unit& u, int wr, int wc, int fr, int fq) const {
        const int row0 = u.pm * 256 + wr * 64 + fr;
        const bool l0 = LNP == nullptr;
        if (l0 && u.pn >= 12 && u.pn < 20) {
            const int col0 = 3072 + (u.pn - 12) * 128 + wc * 32 + 8 * fq;
#pragma unroll
            for (int ai = 0; ai < 2; ++ai)
#pragma unroll
                for (int m = 0; m < 4; ++m) { const f32x4 v0 = acc[ai][0][m][0], v1 = acc[ai][0][m][1], g0 = acc[ai][1][m][0], g1 = acc[ai][1][m][1];
                    u32x4 w; w.x = pk2(v0[0] * sigmoid_f(g0[0]), v0[1] * sigmoid_f(g0[1])); w.y = pk2(v0[2] * sigmoid_f(g0[2]), v0[3] * sigmoid_f(g0[3]));
                    w.z = pk2(v1[0] * sigmoid_f(g1[0]), v1[1] * sigmoid_f(g1[1])); w.w = pk2(v1[2] * sigmoid_f(g1[2]), v1[3] * sigmoid_f(g1[3]));
                    *(u32x4*)(P + (size_t)(row0 + ai * 128 + m * 16) * 6144 + col0) = w; }
        } else if (u.pn < 24) {
            const int col0 = u.pn * 256 + wc * 32 + 8 * fq;
            const bool act = l0 ? (u.pn < 4 || u.pn >= 20) : (u.pn >= 16);
#pragma unroll
            for (int ai = 0; ai < 2; ++ai)
#pragma unroll
                for (int m = 0; m < 4; ++m) { bf16_t* rowp = P + (size_t)(row0 + ai * 128 + m * 16) * 6144 + col0;
#pragma unroll
                    for (int bj = 0; bj < 2; ++bj) { f32x4 v0 = acc[ai][bj][m][0], v1 = acc[ai][bj][m][1];
                        if (act) {
#pragma unroll
                            for (int e = 0; e < 4; ++e) { v0[e] = silu_f(v0[e]); v1[e] = silu_f(v1[e]); } }
                        u32x4 w; w.x = pk2(v0[0], v0[1]); w.y = pk2(v0[2], v0[3]); w.z = pk2(v1[0], v1[1]); w.w = pk2(v1[2], v1[3]);
                        *(u32x4*)(rowp + bj * 128) = w; } }
            if (!l0 && u.pn >= 8 && u.pn < 16) {
#pragma unroll
                for (int ai = 0; ai < 2; ++ai)
#pragma unroll
                    for (int m = 0; m < 4; ++m) { float s1 = 0.f, s2 = 0.f;
#pragma unroll
                        for (int bj = 0; bj < 2; ++bj)
#pragma unroll
                            for (int n = 0; n < 2; ++n)
#pragma unroll
                                for (int e = 0; e < 4; ++e) { const float v = acc[ai][bj][m][n][e]; s1 += v; s2 = fmaf(v, v, s2); }
                        s1 += __shfl_xor(s1, 16); s2 += __shfl_xor(s2, 16); s1 += __shfl_xor(s1, 32); s2 += __shfl_xor(s2, 32);
                        if (fq == 0) { f32x2v o; o.x = s1; o.y = s2; *(f32x2v*)(LNP + ((size_t)(row0 + ai * 128 + m * 16) * 32 + (u.pn - 8) * 4 + wc) * 2) = o; } }
            }
        } else if (wc == 0) {
#pragma unroll
            for (int ai = 0; ai < 2; ++ai)
#pragma unroll
                for (int m = 0; m < 4; ++m) { float* rowp = DT + (size_t)(row0 + ai * 128 + m * 16) * 32 + 8 * fq;
                    *(f32x4*)rowp = acc[ai][0][m][0]; *(f32x4*)(rowp + 4) = acc[ai][0][m][1]; }
        }
    }
};
struct EpiOut {
    static constexpr bool PERM = true, AFTER_DRAIN = false;
    bf16_t* Y; const float* gate;
    __device__ __forceinline__ void operator()(const f32x4 (&acc)[2][2][4][2], const pg8::Unit& u, int wr, int wc, int fr, int fq) const {
        const int row0 = u.pm * 256 + wr * 64 + fr, col0 = u.pn * 256 + wc * 32 + 8 * fq;
        const int cond = u.pm < 16 ? 0 : 1 + ((u.pm - 16) >> 2);
        f32x4 gv[2][2];
#pragma unroll
        for (int bj = 0; bj < 2; ++bj)
#pragma unroll
            for (int n = 0; n < 2; ++n) gv[bj][n] = *(const f32x4*)(gate + cond * 3072 + col0 + bj * 128 + n * 4);
#pragma unroll
        for (int ai = 0; ai < 2; ++ai)
#pragma unroll
            for (int m = 0; m < 4; ++m) { bf16_t* rowp = Y + (size_t)(row0 + ai * 128 + m * 16) * 1024 + col0;
#pragma unroll
                for (int bj = 0; bj < 2; ++bj) { const f32x4 v0 = acc[ai][bj][m][0] * gv[bj][0], v1 = acc[ai][bj][m][1] * gv[bj][1];
                    u32x4 w; w.x = pk2(v0[0], v0[1]); w.y = pk2(v0[2], v0[3]); w.z = pk2(v1[0], v1[1]); w.w = pk2(v1[2], v1[3]);
                    *(u32x4*)(rowp + bj * 128) = w; } }
    }
};

__device__ __forceinline__ void conformer_unit(const Params& p, unsigned char* smem, int unit) {
    const int tid = opaque_tid(), row_base = unit * 16;
    int seq0, L; if (row_base < 4096) { seq0 = row_base & ~255; L = 256; } else { seq0 = 4096 + ((row_base - 4096) & ~1023); L = 1024; }
    const int t0 = row_base - seq0, c0 = tid * 2;
    const bf16_t* P = (const bf16_t*)(p.ws + OFF_P); bf16_t* YC = (bf16_t*)(p.ws + OFF_YC);
    float w[31][2];
#pragma unroll
    for (int k = 0; k < 31; ++k) { const f32x2v v = *(const f32x2v*)(p.in[17] + k * 1024 + c0); w[k][0] = v.x; w[k][1] = v.y; }
    float acc[16][2];
    { const f32x2v b = *(const f32x2v*)(p.in[18] + c0);
#pragma unroll
      for (int tt = 0; tt < 16; ++tt) { acc[tt][0] = b.x; acc[tt][1] = b.y; } }
    const bf16_t* Pv = P + 3072 + c0;
    unsigned gtv[16];
#pragma unroll
    for (int tt = 0; tt < 16; ++tt) gtv[tt] = *(const unsigned*)(P + (size_t)(row_base + tt) * 6144 + 5120 + c0);
    unsigned uraw[46];
#pragma unroll
    for (int jr = 0; jr < 46; ++jr) { const int t = t0 - 15 + jr, tc = t < 0 ? 0 : (t >= L ? L - 1 : t); uraw[jr] = *(const unsigned*)(Pv + (size_t)(seq0 + tc) * 6144); }
#pragma unroll
    for (int jr = 0; jr < 46; ++jr) {
        const int t = t0 - 15 + jr; const bool ok = t >= 0 && t < L; const float u0 = ok ? bflo(uraw[jr]) : 0.f, u1 = ok ? bfhi(uraw[jr]) : 0.f;
#pragma unroll
        for (int tt = 0; tt < 16; ++tt) { const int k = jr - tt; if (k >= 0 && k < 31) { acc[tt][0] = fmaf(w[k][0], u0, acc[tt][0]); acc[tt][1] = fmaf(w[k][1], u1, acc[tt][1]); } }
    }
    float* red1 = (float*)smem; float* red2 = red1 + 16 * 512; float* stat = red2 + 16 * 512;
#pragma unroll
    for (int tt = 0; tt < 16; ++tt) { red1[tt * 512 + tid] = acc[tt][0] + acc[tt][1]; red2[tt * 512 + tid] = acc[tt][0] * acc[tt][0] + acc[tt][1] * acc[tt][1]; }
    __syncthreads();
    { const int tt = tid >> 5, q = tid & 31; float s1 = 0.f, s2 = 0.f;
#pragma unroll
      for (int i = 0; i < 16; ++i) { s1 += red1[tt * 512 + q + 32 * i]; s2 += red2[tt * 512 + q + 32 * i]; }
#pragma unroll
      for (int o = 1; o < 32; o <<= 1) { s1 += __shfl_xor(s1, o); s2 += __shfl_xor(s2, o); }
      const float mean = s1 * (1.f / 1024.f), var = fmaxf(s2 * (1.f / 1024.f) - mean * mean, 0.f);
      if (q == 0) { stat[tt * 2] = mean; stat[tt * 2 + 1] = rsqrtf(var + 1e-5f); } }
    __syncthreads();
    const f32x2v lg = *(const f32x2v*)(p.in[19] + c0), lb = *(const f32x2v*)(p.in[20] + c0);
#pragma unroll
    for (int tt = 0; tt < 16; ++tt) {
        const int row = row_base + tt; const float mean = stat[tt * 2], rstd = stat[tt * 2 + 1];
        const unsigned gt = gtv[tt];
        float v0 = (acc[tt][0] - mean) * rstd * lg.x + lb.x, v1 = (acc[tt][1] - mean) * rstd * lg.y + lb.y;
        v0 = silu_f(v0) * bflo(gt); v1 = silu_f(v1) * bfhi(gt);
        *(unsigned*)(YC + (size_t)row * 2048 + 1024 + c0) = pk2(v0, v1);
    }
    __syncthreads();
}

struct DtRaw { float bias, alog, r0, r1; };
__device__ __forceinline__ DtRaw dt_load(const Params& p, int row0, int g, int tid) {
    const int wave = tid >> 6, lane = tid & 63, hh = wave >> 1, dir = wave & 1, h = g * 4 + hh;
    const float* DT = (const float*)(p.ws + OFF_DT) + (size_t)row0 * 32 + dir * 16 + h;
    DtRaw d; d.bias = p.in[dir ? 12 : 11][h]; d.alog = p.in[dir ? 14 : 13][h]; d.r0 = DT[(2 * lane) * 32]; d.r1 = DT[(2 * lane + 1) * 32]; return d;
}
__device__ __forceinline__ void dt_compute(const DtRaw& d, float* vdt, float* vcum, int tid, float* vw = nullptr) {
    const int wave = tid >> 6, lane = tid & 63, hh = wave >> 1, dir = wave & 1;
    const float a = -expf(d.alog);
    const float d0 = softplus_f(d.r0 + d.bias), d1 = softplus_f(d.r1 + d.bias);
    const float v0 = d0 * a, v1 = d1 * a, s = v0 + v1;
    float inc = s;
#pragma unroll
    for (int o = 1; o < 64; o <<= 1) { const float t = __shfl_up(inc, o); if (lane >= o) inc += t; }
    const float exc = inc - s, P0 = exc + v0;
    float* cd = vcum + (hh * 2 + dir) * 128; float* dd = vdt + (hh * 2 + dir) * 128;
    if (dir == 0) { cd[2 * lane] = P0; cd[2 * lane + 1] = inc; }
    else { const float total = __shfl(inc, 63); cd[2 * lane] = total - exc; cd[2 * lane + 1] = total - P0; }
    dd[2 * lane] = d0; dd[2 * lane + 1] = d1;
    if (vw != nullptr) {
        float* wd = vw + (hh * 2 + dir) * 128;
        if (dir == 0) { const float pe = __shfl(inc, (lane & ~7) | 7); wd[2 * lane] = __expf(pe - P0) * d0; wd[2 * lane + 1] = __expf(pe - inc) * d1; }
        else { const float total = __shfl(inc, 63), s0 = total - exc, s1 = total - P0, sb = __shfl(s0, lane & ~7); wd[2 * lane] = __expf(sb - s0) * d0; wd[2 * lane + 1] = __expf(sb - s1) * d1; }
    }
}
struct CwRaw { f32x4 w0, w1; float ad; };
__device__ __forceinline__ const float* conv_w_src(const Params& p, int g, int q) { const int k = q >> 7, c4 = (q & 127) * 4;
    const int gch = c4 < 256 ? g * 256 + c4 : (c4 < 384 ? 1024 + g * 128 + (c4 - 256) : 1536 + g * 128 + (c4 - 384));
    return k < 4 ? p.in[9] + k * 2048 + gch : p.in[10] + gch; }
__device__ __forceinline__ CwRaw conv_w_load(const Params& p, int g, int tid) {
    CwRaw r; r.w0 = *(const f32x4*)conv_w_src(p, g, tid); r.w1 = *(const f32x4*)conv_w_src(p, g, 512 + (tid & 127)); r.ad = p.in[15][g * 4 + (tid & 3)]; return r;
}
__device__ __forceinline__ void conv_w_store(const CwRaw& r, float* cwl, int tid) {
    *(f32x4*)(cwl + (tid >> 7) * 512 + (tid & 127) * 4) = r.w0;
    if (tid < 128) *(f32x4*)(cwl + 2048 + tid * 4) = r.w1;
    if (tid < 4) cwl[2560 + tid] = r.ad;
}
__device__ __forceinline__ void conv_load4(const bf16_t* P, int seq0, int L, int row0, int j0, int cc0, u32x4 (&raw)[7]) {
#pragma unroll
    for (int rr = 0; rr < 7; ++rr) { const int grow = row0 + j0 - 2 + rr, gc = grow < seq0 ? seq0 : (grow >= seq0 + L ? seq0 + L - 1 : grow);
        const u32x4 v = *(const u32x4*)(P + (size_t)gc * 6144 + 1024 + cc0); raw[rr] = (grow == gc) ? v : (u32x4){0u, 0u, 0u, 0u}; }
}
__device__ __forceinline__ void conv_compute4(const float* cwl, int lc0, const u32x4 (&raw)[7], float (&out)[4][8]) {
    float w[4][8], b[8];
#pragma unroll
    for (int k = 0; k < 4; ++k) { const f32x4 a = *(const f32x4*)(cwl + k * 512 + lc0), c = *(const f32x4*)(cwl + k * 512 + lc0 + 4);
        w[k][0] = a[0]; w[k][1] = a[1]; w[k][2] = a[2]; w[k][3] = a[3]; w[k][4] = c[0]; w[k][5] = c[1]; w[k][6] = c[2]; w[k][7] = c[3]; }
    { const f32x4 a = *(const f32x4*)(cwl + 2048 + lc0), c = *(const f32x4*)(cwl + 2048 + lc0 + 4); b[0] = a[0]; b[1] = a[1]; b[2] = a[2]; b[3] = a[3]; b[4] = c[0]; b[5] = c[1]; b[6] = c[2]; b[7] = c[3]; }
#pragma unroll
    for (int jj = 0; jj < 4; ++jj) {
        float a[8];
#pragma unroll
        for (int e = 0; e < 8; ++e) a[e] = b[e];
#pragma unroll
        for (int k = 0; k < 4; ++k) { float x[8]; unpack8(raw[jj + k], x);
#pragma unroll
            for (int e = 0; e < 8; ++e) a[e] = fmaf(w[k][e], x[e], a[e]); }
#pragma unroll
        for (int e = 0; e < 8; ++e) out[jj][e] = silu_f(a[e]);
    }
}
__device__ __forceinline__ void seq_of_row(int row0, int& seq0, int& L) { if (row0 < 4096) { seq0 = row0 & ~255; L = 256; } else { seq0 = 4096 + ((row0 - 4096) & ~1023); L = 1024; } }

__device__ __forceinline__ void sstate_unit(const Params& p, unsigned char* smem, int unit) {
    const int tid = opaque_tid(), wave = tid >> 6, lane = tid & 63, fr = lane & 15, fq = lane >> 4;
    const int cgi = unit >> 2, g = unit & 3, row0 = cgi * 128; int seq0, L; seq_of_row(row0, seq0, L);
    const bf16_t* P = (const bf16_t*)(p.ws + OFF_P); bf16_t* SST = (bf16_t*)p.out; float* DEC = (float*)(p.ws + OFF_DEC);
    bf16_t* BT = (bf16_t*)smem; bf16_t* XTf = BT + 128 * LDP; bf16_t* XTb = XTf + 128 * LDP; float* vdt = (float*)(smem + 104448); float* vcum = (float*)(smem + 108544);
    float* cwl = (float*)(smem + 112640);
    const int chl = (tid & 15) * 8, j0 = (tid >> 4) * 4;
    u32x4 rawB[7], rawX[7], rawC[7];
    bf16_t* CVX = (bf16_t*)(p.ws + OFF_P) + 4096 + g * 256; bf16_t* CVBC = (bf16_t*)(p.ws + OFF_H) + g * 128;
    const DtRaw dtr = dt_load(p, row0, g, tid);
    const CwRaw cwr = conv_w_load(p, g, tid);
    conv_load4(P, seq0, L, row0, j0, 1024 + g * 128 + chl, rawB);
    conv_load4(P, seq0, L, row0, j0, 1536 + g * 128 + chl, rawC);
    conv_load4(P, seq0, L, row0, j0, g * 256 + chl, rawX);
    conv_w_store(cwr, cwl, tid);
    dt_compute(dtr, vdt, vcum, tid);
    __syncthreads();
    if (tid < 8) { const int hh = tid >> 1, dir = tid & 1; DEC[(cgi * 16 + g * 4 + hh) * 2 + dir] = expf(dir == 0 ? vcum[(hh * 2) * 128 + 127] : vcum[(hh * 2 + 1) * 128]); }
#pragma unroll
    for (int pair = 0; pair < 2; ++pair) {
        if (pair) __syncthreads();
#ifdef DUP_SCONV
#pragma unroll 1
        for (int rep_ = 0; rep_ < 2; ++rep_) { asm volatile("" ::: "memory");
#endif
        { if (pair == 0) {
              float o[4][8]; conv_compute4(cwl, 256 + chl, rawB, o);
#pragma unroll
              for (int e = 0; e < 8; ++e) { u32x2 a; a.x = pk2(o[0][e], o[1][e]); a.y = pk2(o[2][e], o[3][e]); *(u32x2*)(BT + swz(chl + e, j0)) = a; }
#pragma unroll
              for (int jj = 0; jj < 4; ++jj) { u32x4 a; a.x = pk2(o[jj][0], o[jj][1]); a.y = pk2(o[jj][2], o[jj][3]); a.z = pk2(o[jj][4], o[jj][5]); a.w = pk2(o[jj][6], o[jj][7]);
                  *(u32x4*)(CVBC + (size_t)(row0 + j0 + jj) * 1024 + chl) = a; }
              conv_compute4(cwl, 384 + chl, rawC, o);
#pragma unroll
              for (int jj = 0; jj < 4; ++jj) { u32x4 a; a.x = pk2(o[jj][0], o[jj][1]); a.y = pk2(o[jj][2], o[jj][3]); a.z = pk2(o[jj][4], o[jj][5]); a.w = pk2(o[jj][6], o[jj][7]);
                  *(u32x4*)(CVBC + (size_t)(row0 + j0 + jj) * 1024 + 512 + chl) = a; }
          }
          const int hh = pair * 2 + (chl >> 6);
          float o[4][8]; conv_compute4(cwl, pair * 128 + chl, rawX, o);
#pragma unroll
          for (int jj = 0; jj < 4; ++jj) { u32x4 a; a.x = pk2(o[jj][0], o[jj][1]); a.y = pk2(o[jj][2], o[jj][3]); a.z = pk2(o[jj][4], o[jj][5]); a.w = pk2(o[jj][6], o[jj][7]);
              *(u32x4*)(CVX + (size_t)(row0 + j0 + jj) * 6144 + pair * 128 + chl) = a; }
          float wf[4], wb[4]; const float pf127 = vcum[(hh * 2) * 128 + 127], sb0 = vcum[(hh * 2 + 1) * 128];
#pragma unroll
          for (int jj = 0; jj < 4; ++jj) { wf[jj] = vdt[(hh * 2) * 128 + j0 + jj] * __expf(pf127 - vcum[(hh * 2) * 128 + j0 + jj]); wb[jj] = vdt[(hh * 2 + 1) * 128 + j0 + jj] * __expf(sb0 - vcum[(hh * 2 + 1) * 128 + j0 + jj]); }
#pragma unroll
          for (int e = 0; e < 8; ++e) { u32x2 a, c;
              a.x = pk2(o[0][e] * wf[0], o[1][e] * wf[1]); a.y = pk2(o[2][e] * wf[2], o[3][e] * wf[3]);
              c.x = pk2(o[0][e] * wb[0], o[1][e] * wb[1]); c.y = pk2(o[2][e] * wb[2], o[3][e] * wb[3]);
              *(u32x2*)(XTf + swz(chl + e, j0)) = a; *(u32x2*)(XTb + swz(chl + e, j0)) = c; }
        }
#ifdef DUP_SCONV
        }
#endif
        __syncthreads();
        if (pair == 0) conv_load4(P, seq0, L, row0, j0, g * 256 + 128 + chl, rawX);
        const int hd = wave >> 1, hl = hd >> 1, dir = hd & 1, nhalf = wave & 1;
        const bf16_t* XT = (dir ? XTb : XTf);
        f32x4 acc[4][4];
#pragma unroll
        for (int m = 0; m < 4; ++m)
#pragma unroll
            for (int nt = 0; nt < 4; ++nt) acc[m][nt] = (f32x4){0.f, 0.f, 0.f, 0.f};
#pragma unroll
        for (int ks = 0; ks < 4; ++ks) { bf16x8 a[4], b[4];
#pragma unroll
            for (int m = 0; m < 4; ++m) a[m] = *(const bf16x8*)(XT + swz(hl * 64 + m * 16 + fr, ks * 32 + fq * 8));
#pragma unroll
            for (int nt = 0; nt < 4; ++nt) b[nt] = *(const bf16x8*)(BT + swz(nhalf * 64 + nt * 16 + fr, ks * 32 + fq * 8));
#pragma unroll
            for (int m = 0; m < 4; ++m)
#pragma unroll
                for (int nt = 0; nt < 4; ++nt) acc[m][nt] = mfma16(b[nt], a[m], acc[m][nt]); }
        bf16_t* S = SST + ((size_t)(cgi * 16 + g * 4 + pair * 2 + hl) * 2 + dir) * 8192;
#pragma unroll
        for (int m = 0; m < 4; ++m)
#pragma unroll
            for (int nt = 0; nt < 4; ++nt) { u32x2 o; o.x = pk2(acc[m][nt][0], acc[m][nt][1]); o.y = pk2(acc[m][nt][2], acc[m][nt][3]);
                *(u32x2*)(S + (m * 16 + fr) * 128 + nhalf * 64 + nt * 16 + 4 * fq) = o; }
    }
    __syncthreads();
}


__device__ __forceinline__ void prefix_phase(const Params& p) {
    const int tid = opaque_tid();
    bf16_t* SST = (bf16_t*)p.out; const float* DEC = (const float*)(p.ws + OFF_DEC);
    for (int task = blockIdx.x; task < 1536; task += gridDim.x) {
        const int item = task >> 1, s = item >> 5, h = (item >> 1) & 15, dir = item & 1, e8 = ((task & 1) * 512 + tid) * 8;
        const int cg0 = s < 16 ? s * 2 : 32 + (s - 16) * 8, nc = s < 16 ? 2 : 8;
        float hv[8];
        if (s >= 16) { const float* h0 = p.in[dir ? 3 : 2] + (size_t)((s - 16) * 16 + h) * 8192 + e8; const f32x4 a = *(const f32x4*)h0, c = *(const f32x4*)(h0 + 4);
            hv[0] = a[0]; hv[1] = a[1]; hv[2] = a[2]; hv[3] = a[3]; hv[4] = c[0]; hv[5] = c[1]; hv[6] = c[2]; hv[7] = c[3]; }
        else {
#pragma unroll
            for (int e = 0; e < 8; ++e) hv[e] = 0.f; }
        u32x4 sv[8]; float dc[8];
#pragma unroll
        for (int k = 0; k < 8; ++k) { sv[k] = (u32x4){0u, 0u, 0u, 0u}; dc[k] = 0.f;
            if (k < nc) { const int c = dir ? nc - 1 - k : k; const size_t idx = (size_t)((cg0 + c) * 16 + h) * 2 + dir; sv[k] = *(const u32x4*)(SST + idx * 8192 + e8); dc[k] = DEC[idx]; } }
#pragma unroll
        for (int k = 0; k < 8; ++k) {
            if (k < nc) { const int c = dir ? nc - 1 - k : k; const size_t idx = (size_t)((cg0 + c) * 16 + h) * 2 + dir;
                u32x4 o; o.x = pk2(hv[0], hv[1]); o.y = pk2(hv[2], hv[3]); o.z = pk2(hv[4], hv[5]); o.w = pk2(hv[6], hv[7]);
                *(u32x4*)(SST + idx * 8192 + e8) = o;
                float x[8]; unpack8(sv[k], x);
#pragma unroll
                for (int e = 0; e < 8; ++e) hv[e] = fmaf(hv[e], dc[k], x[e]); } }
        if (s < 16) { float* o = p.out + (dir ? OUT_STB : OUT_STF) + (size_t)(s * 16 + h) * 8192 + e8;
            *(f32x4*)o = (f32x4){hv[0], hv[1], hv[2], hv[3]}; *(f32x4*)(o + 4) = (f32x4){hv[4], hv[5], hv[6], hv[7]}; }
    }
}

__device__ __forceinline__ void ssd_y_unit(const Params& p, unsigned char* smem, int unit) {
    const int tid = opaque_tid(), wave = tid >> 6, lane = tid & 63, fr = lane & 15, fq = lane >> 4;
    const int cgi = unit >> 2, g = unit & 3, row0 = cgi * 128; int seq0, L; seq_of_row(row0, seq0, L);
    const int cidx = (row0 - seq0) >> 7, nc = L >> 7, cg0 = seq0 >> 7; const bool is_sample = row0 >= 4096; const int bs = (row0 - 4096) >> 10;
    const bf16_t* P = (const bf16_t*)(p.ws + OFF_P); const bf16_t* SST = (const bf16_t*)p.out; const float* DEC = (const float*)(p.ws + OFF_DEC); bf16_t* YC = (bf16_t*)(p.ws + OFF_YC);
    bf16_t* Cs = (bf16_t*)smem; bf16_t* BM = Cs + 128 * LDP; bf16_t* XT = BM + 128 * LDP; bf16_t* Hf = XT + 64 * LDP; bf16_t* Hb = Hf + 64 * LDP;
    float* vdt = (float*)(smem + 121856); float* vcum = (float*)(smem + 125952);
    float* cwl = (float*)(smem + 130048);
    const bf16_t* CVX = (const bf16_t*)(p.ws + OFF_P) + 4096 + g * 256; const bf16_t* CVBC = (const bf16_t*)(p.ws + OFF_H) + g * 128;
    const int i = wave * 16 + fr;
    f32x4 cb[8];
#ifdef DUP_TOP
#pragma unroll 1
    for (int rep_ = 0; rep_ < 2; ++rep_) { asm volatile("" ::: "memory");
#endif
    { const int chl = (tid & 15) * 8, j0 = (tid >> 4) * 4;
      const DtRaw dtr = dt_load(p, row0, g, tid);
      const float adv = p.in[15][g * 4 + (tid & 3)];
      u32x4 cC[4], cB[4];
#pragma unroll
      for (int jj = 0; jj < 4; ++jj) { cC[jj] = *(const u32x4*)(CVBC + (size_t)(row0 + j0 + jj) * 1024 + 512 + chl); cB[jj] = *(const u32x4*)(CVBC + (size_t)(row0 + j0 + jj) * 1024 + chl); }
      if (tid < 4) cwl[2560 + tid] = adv;
      dt_compute(dtr, vdt, vcum, tid, cwl);
#pragma unroll
      for (int jj = 0; jj < 4; ++jj) { *(u32x4*)(Cs + (j0 + jj) * LDP + chl) = cC[jj]; *(u32x4*)(BM + (j0 + jj) * LDP + chl) = cB[jj]; } }
    __syncthreads();
#ifndef DUP_TOP
    float ssq = 0.f;
    const int grow = row0 + i; const int wave_u = __builtin_amdgcn_readfirstlane(wave);
    const int xchl = (tid & 15) * 4, xj0 = (tid >> 4) * 4;
    u32x4 hin[4]; u32x2 rawx[4]; u32x4 zz[2];
#define Y_LOAD_HEAD(HH) do { const int h_ = g * 4 + (HH); \
        _Pragma("unroll") for (int it = 0; it < 4; ++it) { const int v = tid + 512 * it, dir = v >> 10, e8 = (v & 1023) * 8; hin[it] = *(const u32x4*)(SST + ((size_t)(cgi * 16 + h_) * 2 + dir) * 8192 + e8); } \
        _Pragma("unroll") for (int jj = 0; jj < 4; ++jj) rawx[jj] = *(const u32x2*)(CVX + (size_t)(row0 + xj0 + jj) * 6144 + (HH) * 64 + xchl); \
        _Pragma("unroll") for (int t = 0; t < 2; ++t) zz[t] = *(const u32x4*)(P + (size_t)grow * 6144 + h_ * 64 + t * 32 + 8 * fq); } while (0)
    Y_LOAD_HEAD(0);
#endif
#pragma unroll
    for (int nt = 0; nt < 8; ++nt) cb[nt] = (f32x4){0.f, 0.f, 0.f, 0.f};
#pragma unroll
    for (int ks = 0; ks < 4; ++ks) { const bf16x8 a = *(const bf16x8*)(Cs + i * LDP + ks * 32 + fq * 8);
#pragma unroll
        for (int nt = 0; nt < 8; ++nt) { const bf16x8 b = *(const bf16x8*)(BM + (nt * 16 + fr) * LDP + ks * 32 + fq * 8); cb[nt] = mfma16(b, a, cb[nt]); } }
    __syncthreads();
#ifdef DUP_TOP
    }
#endif
#pragma unroll 1
    for (int hh = 0; hh < 4; ++hh) {
        const int h = g * 4 + hh;
        const float pfi = vcum[(hh * 2) * 128 + i], sbi = vcum[(hh * 2 + 1) * 128 + i];
#ifdef DUP_M
#pragma unroll 1
        for (int rep_ = 0; rep_ < 2; ++rep_) { asm volatile("" ::: "memory");
#endif
#pragma unroll
        for (int nt = 0; nt < 8; ++nt) { const int j0 = nt * 16 + 4 * fq; float mv[4];
            if (nt == wave_u) {
                const f32x4 pfj = *(const f32x4*)(vcum + (hh * 2) * 128 + j0), sbj = *(const f32x4*)(vcum + (hh * 2 + 1) * 128 + j0);
                const f32x4 dfj = *(const f32x4*)(vdt + (hh * 2) * 128 + j0), dbj = *(const f32x4*)(vdt + (hh * 2 + 1) * 128 + j0);
#pragma unroll
                for (int r = 0; r < 4; ++r) { const int j = j0 + r; const float arg = j < i ? pfi - pfj[r] : sbi - sbj[r]; const float ex = __expf(fminf(arg, 0.f));
                    const float m = j < i ? ex * dfj[r] : (j > i ? ex * dbj[r] : dfj[r] + dbj[r]); mv[r] = m * cb[nt][r]; }
            } else {
                const bool lower = nt < wave_u;
                const float e1 = __expf(fminf(lower ? pfi - vcum[(hh * 2) * 128 + nt * 16 + 15] : sbi - vcum[(hh * 2 + 1) * 128 + nt * 16], 0.f));
                const f32x4 wj = *(const f32x4*)(cwl + (hh * 2 + (lower ? 0 : 1)) * 128 + j0);
#pragma unroll
                for (int r = 0; r < 4; ++r) mv[r] = cb[nt][r] * (e1 * wj[r]);
            }
            u32x2 o; o.x = pk2(mv[0], mv[1]); o.y = pk2(mv[2], mv[3]);
            *(u32x2*)(BM + i * LDP + j0) = o; }
#ifdef DUP_M
        }
#endif
#ifdef DUP_STG
#pragma unroll 1
        for (int rep_ = 0; rep_ < 2; ++rep_) { asm volatile("" ::: "memory");
#endif
#pragma unroll
        for (int it = 0; it < 4; ++it) { const int v = tid + 512 * it, dir = v >> 10, e8 = (v & 1023) * 8, pp = e8 >> 7;
            const int rho = (pp & ~31) + 16 * ((pp >> 2) & 1) + 4 * ((pp & 31) >> 3) + (pp & 3);
            *(u32x4*)((dir ? Hb : Hf) + rho * LDP + (e8 & 127)) = hin[it]; }
        {
          u32x2 t0, t1, t2, t3;
          t0.x = __builtin_amdgcn_perm(rawx[1].x, rawx[0].x, 0x05040100u); t0.y = __builtin_amdgcn_perm(rawx[3].x, rawx[2].x, 0x05040100u);
          t1.x = __builtin_amdgcn_perm(rawx[1].x, rawx[0].x, 0x07060302u); t1.y = __builtin_amdgcn_perm(rawx[3].x, rawx[2].x, 0x07060302u);
          t2.x = __builtin_amdgcn_perm(rawx[1].y, rawx[0].y, 0x05040100u); t2.y = __builtin_amdgcn_perm(rawx[3].y, rawx[2].y, 0x05040100u);
          t3.x = __builtin_amdgcn_perm(rawx[1].y, rawx[0].y, 0x07060302u); t3.y = __builtin_amdgcn_perm(rawx[3].y, rawx[2].y, 0x07060302u);
          const int xr = (xchl & ~31) + 16 * ((xchl >> 2) & 1) + 4 * ((xchl & 31) >> 3);
          *(u32x2*)(XT + swz(xr + 0, xj0)) = t0; *(u32x2*)(XT + swz(xr + 1, xj0)) = t1; *(u32x2*)(XT + swz(xr + 2, xj0)) = t2; *(u32x2*)(XT + swz(xr + 3, xj0)) = t3; }
#ifdef DUP_STG
        }
#endif
        u32x4 zc[2];
#pragma unroll
        for (int t = 0; t < 2; ++t) zc[t] = zz[t];
        __syncthreads();
        if (hh < 3) Y_LOAD_HEAD(hh + 1);
#ifdef DUP_LD
        asm volatile("" ::: "memory"); if (hh < 3) Y_LOAD_HEAD(hh + 1);
#endif
        f32x4 yd[4], tf[4], tb[4];
#pragma unroll
        for (int nt = 0; nt < 4; ++nt) { yd[nt] = (f32x4){0.f, 0.f, 0.f, 0.f}; tf[nt] = yd[nt]; tb[nt] = yd[nt]; }
#ifdef DUP_MFMA
#pragma unroll 1
        for (int rep_ = 0; rep_ < 2; ++rep_) { asm volatile("" ::: "memory");
#endif
#pragma unroll 2
        for (int ks = 0; ks < 4; ++ks) { const bf16x8 am = *(const bf16x8*)(BM + i * LDP + ks * 32 + fq * 8), ac = *(const bf16x8*)(Cs + i * LDP + ks * 32 + fq * 8);
#pragma unroll
            for (int nt = 0; nt < 4; ++nt) { const int ro = (nt * 16 + fr) * LDP + ks * 32 + fq * 8;
                yd[nt] = mfma16(*(const bf16x8*)(XT + swz(nt * 16 + fr, ks * 32 + fq * 8)), am, yd[nt]); tf[nt] = mfma16(*(const bf16x8*)(Hf + ro), ac, tf[nt]); tb[nt] = mfma16(*(const bf16x8*)(Hb + ro), ac, tb[nt]); } }
#ifdef DUP_MFMA
        }
#pragma unroll
        for (int nt = 0; nt < 4; ++nt) { yd[nt] *= 0.5f; tf[nt] *= 0.5f; tb[nt] *= 0.5f; }
#endif
        const float ef = __expf(pfi), eb = __expf(sbi), ad = cwl[2560 + hh];
#ifdef DUP_COMB
        float ssq_keep = ssq;
#pragma unroll 1
        for (int rep_ = 0; rep_ < 2; ++rep_) { asm volatile("" ::: "memory"); if (rep_ == 1) ssq = ssq_keep;
#endif
#pragma unroll
        for (int t = 0; t < 2; ++t) { float zf[8]; unpack8(zc[t], zf); float yv[8];
#pragma unroll
            for (int n = 0; n < 2; ++n)
#pragma unroll
                for (int r = 0; r < 4; ++r) { const int nt = 2 * t + n; const float x = bf2f(XT[swz(nt * 16 + 4 * fq + r, i)]);
                    float y = yd[nt][r] + ef * tf[nt][r] + eb * tb[nt][r] + ad * x; y *= zf[4 * n + r]; ssq = fmaf(y, y, ssq); yv[4 * n + r] = y; }
            u32x4 o; o.x = pk2(yv[0], yv[1]); o.y = pk2(yv[2], yv[3]); o.z = pk2(yv[4], yv[5]); o.w = pk2(yv[6], yv[7]);
            *(u32x4*)(YC + (size_t)grow * 2048 + h * 64 + t * 32 + 8 * fq) = o; }
#ifdef DUP_COMB
        }
#endif
        __syncthreads();
    }
#undef Y_LOAD_HEAD
    ssq += __shfl_xor(ssq, 16); ssq += __shfl_xor(ssq, 32);
    const float rs = rsqrtf(ssq * (1.f / 256.f) + 1e-5f);
    { u32x4 yy[4][2]; f32x4 nwv[4][2][2];
#pragma unroll
      for (int hh = 0; hh < 4; ++hh)
#pragma unroll
          for (int t = 0; t < 2; ++t) { const int ch = g * 256 + hh * 64 + t * 32 + 8 * fq; yy[hh][t] = *(const u32x4*)(YC + (size_t)grow * 2048 + ch);
              nwv[hh][t][0] = *(const f32x4*)(p.in[16] + ch); nwv[hh][t][1] = *(const f32x4*)(p.in[16] + ch + 4); }
#pragma unroll
      for (int hh = 0; hh < 4; ++hh)
#pragma unroll
          for (int t = 0; t < 2; ++t) { const int ch = g * 256 + hh * 64 + t * 32 + 8 * fq; float yf[8]; unpack8(yy[hh][t], yf); const f32x4 n0 = nwv[hh][t][0], n1 = nwv[hh][t][1];
              u32x4 o; o.x = pk2(yf[0] * rs * n0[0], yf[1] * rs * n0[1]); o.y = pk2(yf[2] * rs * n0[2], yf[3] * rs * n0[3]); o.z = pk2(yf[4] * rs * n1[0], yf[5] * rs * n1[1]); o.w = pk2(yf[6] * rs * n1[2], yf[7] * rs * n1[3]);
              *(u32x4*)(YC + (size_t)grow * 2048 + ch) = o; } }
    __syncthreads();
}

__device__ __forceinline__ void gmlp_phase(const Params& p, unsigned char* smem) {
    const int tid = opaque_tid(), wave = tid >> 6, lane = tid & 63, fr = lane & 15, fq = lane >> 4;
    const int g = blockIdx.x & 15, cstep = gridDim.x >> 4;
    const bf16_t* P = (const bf16_t*)(p.ws + OFF_P); bf16_t* YC = (bf16_t*)(p.ws + OFF_YC); const float* LNP = (const float*)(p.ws + OFF_DT);
    bf16_t* Ws = (bf16_t*)smem; bf16_t* VT = Ws + 128 * LDP; float* stat = (float*)(smem + 69632);
    { const float* wsrc = p.in[29] + (size_t)g * 16384;
#pragma unroll
      for (int it = 0; it < 4; ++it) { const int bb = tid + 512 * it, row = bb >> 4, c8 = (bb & 15) * 8; const f32x4 a = *(const f32x4*)(wsrc + row * 128 + c8), c = *(const f32x4*)(wsrc + row * 128 + c8 + 4);
          u32x4 o; o.x = pk2(a[0], a[1]); o.y = pk2(a[2], a[3]); o.z = pk2(c[0], c[1]); o.w = pk2(c[2], c[3]); *(u32x4*)(Ws + row * LDP + c8) = o; } }
    const int d0 = (tid & 15) * 8, vj0 = (tid >> 4) * 4, vch = g * 128 + d0;
    const f32x4 ga = *(const f32x4*)(p.in[27] + vch), gb = *(const f32x4*)(p.in[27] + vch + 4), ba = *(const f32x4*)(p.in[28] + vch), bb = *(const f32x4*)(p.in[28] + vch + 4);
    const float gg[8] = {ga[0], ga[1], ga[2], ga[3], gb[0], gb[1], gb[2], gb[3]}, be[8] = {ba[0], ba[1], ba[2], ba[3], bb[0], bb[1], bb[2], bb[3]};
    const int i = wave * 16 + fr;
    const float bsi = p.in[30][g * 128 + i];
    f32x4 st[4]; u32x4 vr[4];
#define GM_LOAD(CG) do { const int r0_ = (CG) * 128; const float* lp = LNP + ((size_t)(r0_ + (tid >> 2)) * 32 + (tid & 3) * 8) * 2; \
        _Pragma("unroll") for (int k = 0; k < 4; ++k) st[k] = *(const f32x4*)(lp + 4 * k); \
        _Pragma("unroll") for (int jj = 0; jj < 4; ++jj) vr[jj] = *(const u32x4*)(P + (size_t)(r0_ + vj0 + jj) * 6144 + 2048 + vch); } while (0)
    if ((int)(blockIdx.x >> 4) < 96) GM_LOAD(blockIdx.x >> 4);
#pragma unroll 1
    for (int cgi = blockIdx.x >> 4; cgi < 96; cgi += cstep) {
        const int row0 = cgi * 128; const size_t grow = (size_t)(row0 + i);
        u32x4 uu[4], gt[4];
#pragma unroll
        for (int t = 0; t < 4; ++t) { const int ch = g * 128 + t * 32 + 8 * fq; uu[t] = *(const u32x4*)(P + grow * 6144 + ch); gt[t] = *(const u32x4*)(P + grow * 6144 + 4096 + ch); }
        { float s1 = st[0][0] + st[0][2] + st[1][0] + st[1][2] + st[2][0] + st[2][2] + st[3][0] + st[3][2], s2 = st[0][1] + st[0][3] + st[1][1] + st[1][3] + st[2][1] + st[2][3] + st[3][1] + st[3][3];
          s1 += __shfl_xor(s1, 1); s2 += __shfl_xor(s2, 1); s1 += __shfl_xor(s1, 2); s2 += __shfl_xor(s2, 2);
          const float mean = s1 * (1.f / 2048.f), var = fmaxf(s2 * (1.f / 2048.f) - mean * mean, 0.f);
          if ((tid & 3) == 0) { stat[(tid >> 2) * 2] = mean; stat[(tid >> 2) * 2 + 1] = rsqrtf(var + 1e-5f); } }
        __syncthreads();
        { float vn[4][8];
#pragma unroll
          for (int jj = 0; jj < 4; ++jj) { float x[8]; unpack8(vr[jj], x); const float mean = stat[(vj0 + jj) * 2], rstd = stat[(vj0 + jj) * 2 + 1];
#pragma unroll
              for (int e = 0; e < 8; ++e) vn[jj][e] = (x[e] - mean) * rstd * gg[e] + be[e]; }
#pragma unroll
          for (int e = 0; e < 8; ++e) { u32x2 o; o.x = pk2(vn[0][e], vn[1][e]); o.y = pk2(vn[2][e], vn[3][e]);
              const int rho = (d0 & ~31) + 16 * (e >> 2) + ((d0 & 31) >> 1) + (e & 3);
              *(u32x2*)(VT + swz(rho, vj0)) = o; } }
        __syncthreads();
        if (cgi + cstep < 96) GM_LOAD(cgi + cstep);
        f32x4 acc[8];
#pragma unroll
        for (int nt = 0; nt < 8; ++nt) acc[nt] = (f32x4){0.f, 0.f, 0.f, 0.f};
#pragma unroll
        for (int ks = 0; ks < 4; ++ks) { const bf16x8 a = *(const bf16x8*)(Ws + i * LDP + ks * 32 + fq * 8);
#pragma unroll
            for (int nt = 0; nt < 8; ++nt) acc[nt] = mfma16(*(const bf16x8*)(VT + swz(nt * 16 + fr, ks * 32 + fq * 8)), a, acc[nt]); }
#pragma unroll
        for (int t = 0; t < 4; ++t) { const int ch = g * 128 + t * 32 + 8 * fq; float uf[8], gf[8]; unpack8(uu[t], uf); unpack8(gt[t], gf);
            const f32x4 a0 = acc[2 * t], a1 = acc[2 * t + 1];
            u32x4 o; o.x = pk2(uf[0] * (a0[0] + bsi) * gf[0], uf[1] * (a0[1] + bsi) * gf[1]); o.y = pk2(uf[2] * (a0[2] + bsi) * gf[2], uf[3] * (a0[3] + bsi) * gf[3]);
            o.z = pk2(uf[4] * (a1[0] + bsi) * gf[4], uf[5] * (a1[1] + bsi) * gf[5]); o.w = pk2(uf[6] * (a1[2] + bsi) * gf[6], uf[7] * (a1[3] + bsi) * gf[7]);
            *(u32x4*)(YC + grow * 2048 + ch) = o; }
        __syncthreads();
    }
}

__device__ __forceinline__ void ln_phase(const Params& p, int layer) {
    const int tid = opaque_tid(), wave = tid >> 6, lane = tid & 63;
    const float* G = p.in[layer ? 32 : 22]; const float* B = p.in[layer ? 33 : 23];
    const float* MODS = (const float*)(p.ws + OFF_MODS) + 9 * 3072; bf16_t* H = (bf16_t*)(p.ws + OFF_H);
    const bf16_t* Yg = (const bf16_t*)(p.ws + OFF_P); const float* POSR = (const float*)(p.ws + OFF_POSR); const float* POSC = (const float*)(p.ws + OFF_POSC);
    for (int rb = (blockIdx.x * 8 + wave) * 3; rb < NTOK; rb += gridDim.x * 24) {
        f32x4 v[3][4]; u32x2 yv[3][4]; f32x4 pe[3][4];
#pragma unroll
        for (int k = 0; k < 3; ++k) { const int r = rb + k;
            const float* xr = layer ? p.out + (size_t)r * 1024 : (r < 4096 ? p.in[0] + (size_t)r * 1024 : p.in[1] + (size_t)(r - 4096) * 1024);
            const int l = (r - 4096) & 1023;
#pragma unroll
            for (int i = 0; i < 4; ++i) { const int c = lane * 4 + 256 * i; v[k][i] = *(const f32x4*)(xr + c); yv[k][i] = *(const u32x2*)(Yg + (size_t)r * 1024 + c);
                pe[k][i] = (f32x4){0.f, 0.f, 0.f, 0.f};
                if (layer == 0 && r >= 4096) pe[k][i] = *(const f32x4*)(c < 512 ? POSR + (l >> 6) * 512 + c : POSC + (l & 63) * 512 + (c - 512)); } }
#pragma unroll
        for (int k = 0; k < 3; ++k) { const int r = rb + k; float s = 0.f;
#pragma unroll
            for (int i = 0; i < 4; ++i) { const f32x4 y = (f32x4){bflo(yv[k][i].x), bfhi(yv[k][i].x), bflo(yv[k][i].y), bfhi(yv[k][i].y)};
                v[k][i] = (v[k][i] + pe[k][i]) * ALPHA_C + y; s += v[k][i][0] + v[k][i][1] + v[k][i][2] + v[k][i][3]; }
#pragma unroll
            for (int o = 1; o < 64; o <<= 1) s += __shfl_xor(s, o);
            const float mean = s * (1.f / 1024.f); float q = 0.f;
#pragma unroll
            for (int i = 0; i < 4; ++i) { v[k][i] -= mean; q += v[k][i][0] * v[k][i][0] + v[k][i][1] * v[k][i][1] + v[k][i][2] * v[k][i][2] + v[k][i][3] * v[k][i][3]; }
#pragma unroll
            for (int o = 1; o < 64; o <<= 1) q += __shfl_xor(q, o);
            const float rstd = rsqrtf(q * (1.f / 1024.f) + 1e-5f);
            const int cond = cond_of_row(r); float* xo = p.out + (size_t)r * 1024;
#pragma unroll
            for (int i = 0; i < 4; ++i) { const int c = lane * 4 + 256 * i; const f32x4 y = v[k][i] * rstd * *(const f32x4*)(G + c) + *(const f32x4*)(B + c);
                *(f32x4*)(xo + c) = y;
                if (layer == 0) { const f32x4 sh = *(const f32x4*)(MODS + cond * 3072 + c), sc = *(const f32x4*)(MODS + cond * 3072 + 1024 + c); const f32x4 h = y * (sc + 1.0f) + sh;
                    u32x2 o; o.x = pk2(h[0], h[1]); o.y = pk2(h[2], h[3]); *(u32x2*)(H + (size_t)r * 1024 + c) = o; } } }
    }
}

constexpr int NPHASE = 11;
template <int PH> __device__ __forceinline__ void run_phase(const Params& p, unsigned char* shm) {
    const bf16_t* H = (const bf16_t*)(p.ws + OFF_H); bf16_t* Pb = (bf16_t*)(p.ws + OFF_P); const bf16_t* YC = (const bf16_t*)(p.ws + OFF_YC);
    const float* MODS = (const float*)(p.ws + OFF_MODS);
    if constexpr (PH == 0) phase_prep(p, shm);
    if constexpr (PH == 1) phase_conv_h0(p, shm);
    if constexpr (PH == 2 || PH == 7) {
        pg8::Gemm g; g.A = H; g.Bt = (const bf16_t*)(p.ws + (PH == 2 ? OFF_WT0 : OFF_WT1)); g.M = NTOK; g.N = PH == 2 ? 6400 : 6144; g.K = 1024;
        pg8::StaticOrder S; S.init(g.M, g.N, (int)gridDim.x, (int)blockIdx.x);
        EpiIn E; E.P = Pb; E.DT = (float*)(p.ws + OFF_DT); E.LNP = PH == 2 ? nullptr : (float*)(p.ws + OFF_DT);
        pg8::gemm_phase<EpiIn, pg8::StaticOrder, false>((PG8_LAS unsigned char*)shm, g, S, E, nullptr);
    }
    if constexpr (PH == 3 || PH == 4) {
        const bool bal = gridDim.x == 256;
#ifndef DUP_YUNIT
#define DUP_YUNIT 0
#endif
        for (int u = blockIdx.x; u < 384; u += gridDim.x) { if (PH == 3) sstate_unit(p, shm, u); else { for (int rep_ = 0; rep_ <= DUP_YUNIT; ++rep_) ssd_y_unit(p, shm, u); } }
#ifndef CONF_P3
#define CONF_P3 3
#endif
        if (bal) { if (blockIdx.x >= 128) { const int c0 = ((int)blockIdx.x - 128) * 6 + (PH == 3 ? 0 : CONF_P3); const int nk = PH == 3 ? CONF_P3 : 6 - CONF_P3; for (int k = 0; k < nk; ++k) conformer_unit(p, shm, c0 + k); } }
        else if (PH == 3) { for (int u = gridDim.x - 1 - blockIdx.x; u < 768; u += gridDim.x) conformer_unit(p, shm, u); }
    }
    if constexpr (PH == 5 || PH == 9) {
        pg8::Gemm g; g.A = YC; g.Bt = (const bf16_t*)(p.ws + (PH == 5 ? OFF_WO0 : OFF_WO1)); g.M = NTOK; g.N = 1024; g.K = 2048;
        pg8::StaticOrder S; S.init(g.M, g.N, (int)gridDim.x, (int)blockIdx.x);
        EpiOut E; E.Y = (bf16_t*)(p.ws + OFF_P); E.gate = MODS + (PH == 5 ? 0 : 9 * 3072) + 2048;
        pg8::gemm_phase<EpiOut, pg8::StaticOrder, false>((PG8_LAS unsigned char*)shm, g, S, E, nullptr);
        if (PH == 5 && gridDim.x == 256 && blockIdx.x >= 192) {
            transpose_tiles<2>(p.in[26], (bf16_t*)(p.ws + OFF_WT1), (float*)shm, (int)blockIdx.x - 192, 64);
            transpose_tiles<3>(p.in[31], (bf16_t*)(p.ws + OFF_WO1), (float*)shm, (int)blockIdx.x - 192, 64); }
    }
    if constexpr (PH == 6) ln_phase(p, 0);
    if constexpr (PH == 8) gmlp_phase(p, shm);
    if constexpr (PH == 10) ln_phase(p, 1);
    if constexpr (PH == 11) prefix_phase(p);
}

#ifndef MULTI_LAUNCH
__global__ __launch_bounds__(512, 2) void mega_kernel(Params p) {
    extern __shared__ __attribute__((aligned(16))) unsigned char shm[];
    cg::grid_group grid = cg::this_grid();
    if (p.ws == nullptr) grid.sync();
    volatile LAS unsigned* st = (volatile LAS unsigned*)((LAS unsigned char*)shm + 163824);
    if (threadIdx.x == 0) { st[0] = 0u; st[1] = 0u; st[2] = 0u; st[3] = 0u; }
    __syncthreads();
    unsigned* bar = (unsigned*)(p.ws + OFF_BAR);
    constexpr unsigned kInitWord = XCD_BAR_WORDS + 64, kMagic = 0x600DF00Du;
    if (blockIdx.x == 0) {
        for (int i = threadIdx.x; i < XCD_BAR_WORDS; i += 512) __hip_atomic_store(bar + i, 0u, __ATOMIC_RELAXED, __HIP_MEMORY_SCOPE_AGENT);
        asm volatile("s_waitcnt vmcnt(0)" ::: "memory");
        __syncthreads();
        if (threadIdx.x == 0) { __builtin_amdgcn_fence(__ATOMIC_RELEASE, "agent"); asm volatile("s_waitcnt vmcnt(0)" ::: "memory");
            __hip_atomic_store(bar + kInitWord, kMagic, __ATOMIC_RELAXED, __HIP_MEMORY_SCOPE_AGENT); }
    }
#ifndef REP_MASK
#define REP_MASK 0
#endif
    run_phase<0>(p, shm);
    if (threadIdx.x == 0) { unsigned sp = 0u; while (__hip_atomic_load(bar + kInitWord, __ATOMIC_RELAXED, __HIP_MEMORY_SCOPE_AGENT) != kMagic) { __builtin_amdgcn_s_sleep(1); if (++sp > (1u << 20)) break; }
        __builtin_amdgcn_fence(__ATOMIC_ACQUIRE, "agent"); }
    __syncthreads();
    const XcdBarrier xb = xcd_barrier_post(bar, st);
#define GSYNC() xcd_barrier(xb)
#define RUNP(k) run_phase<k>(p, shm); GSYNC(); if (REP_MASK & (1 << k)) { run_phase<k>(p, shm); GSYNC(); }
    GSYNC();
    if (blockIdx.x == 0 && threadIdx.x == 0) __hip_atomic_store(bar + kInitWord, 0u, __ATOMIC_RELAXED, __HIP_MEMORY_SCOPE_AGENT);
    RUNP(1) RUNP(2) RUNP(3)
    run_phase<11>(p, shm); GSYNC();
    RUNP(4) RUNP(5)
    RUNP(6)
    RUNP(7) RUNP(8)
    run_phase<9>(p, shm); GSYNC();
    run_phase<10>(p, shm);
}
#else
template <int PH> __global__ __launch_bounds__(512, 2) void phase_kernel(Params p) {
    extern __shared__ __attribute__((aligned(16))) unsigned char shm[];
    run_phase<PH>(p, shm);
}
template <int PH> static void launch_phase(const Params& p, hipStream_t stream) {
    hipFuncSetAttribute((const void*)phase_kernel<PH>, hipFuncAttributeMaxDynamicSharedMemorySize, 163840);
    phase_kernel<PH><<<256, 512, 163840, stream>>>(p);
}
#endif

extern "C" void kernel_launch(void* const* d_in, const int* in_sizes, int n_in, void* d_out, int out_size, void* d_ws, size_t ws_size, hipStream_t stream) {
    Params p{};
    for (int i = 0; i < 34; ++i) p.in[i] = (const float*)d_in[i];
    p.out = (float*)d_out; p.ws = (unsigned char*)d_ws;
    constexpr size_t kDynLds = 163840;
#ifndef MULTI_LAUNCH
    static int grid_blocks = 0;
    if (!grid_blocks) {
        int dev = 0, cus = 0, per_cu = 0;
        hipGetDevice(&dev);
        hipDeviceGetAttribute(&cus, hipDeviceAttributeMultiprocessorCount, dev);
        hipFuncSetAttribute((const void*)mega_kernel, hipFuncAttributeMaxDynamicSharedMemorySize, (int)kDynLds);
        hipOccupancyMaxActiveBlocksPerMultiprocessor(&per_cu, mega_kernel, 512, kDynLds);
        if (per_cu < 1) per_cu = 1;
        grid_blocks = cus * (per_cu > 1 ? 1 : per_cu);
    }
    void* args[] = {&p};
    hipError_t e = hipLaunchCooperativeKernel((void*)mega_kernel, dim3(grid_blocks), dim3(512), args, kDynLds, stream);
    if (e != hipSuccess) fprintf(stderr, "cooperative launch failed: %s (grid %d)\n", hipGetErrorString(e), grid_blocks);
#else
    launch_phase<0>(p, stream); launch_phase<1>(p, stream); launch_phase<2>(p, stream); launch_phase<3>(p, stream); launch_phase<11>(p, stream); launch_phase<4>(p, stream); launch_phase<5>(p, stream);
    launch_phase<6>(p, stream); launch_phase<7>(p, stream); launch_phase<8>(p, stream); launch_phase<9>(p, stream); launch_phase<10>(p, stream);
#endif
}
```

```cpp
#include <hip/hip_runtime.h>
#include <hip/hip_cooperative_groups.h>
#include <cstdio>
namespace cg = cooperative_groups;
namespace pg8 {
#define PG8_LAS __attribute__((address_space(3)))
typedef unsigned short bf16_t;
typedef short bf16x8 __attribute__((ext_vector_type(8)));
typedef float f32x4 __attribute__((ext_vector_type(4)));
typedef unsigned u32x4 __attribute__((ext_vector_type(4)));
constexpr int BM = 256, BK = 64, HALF = 128, HTB = HALF * BK * 2  , STAGE_BYTES = 8 * HTB, NXCD = 8, WGM = 8;

__host__ __device__ __forceinline__ int lds_byte(int r, int c) { const int st = (r >> 4) * 2 + (c >> 5), rr = r & 15, cc = c & 31, ob = rr * 64 + cc * 2; return st * 1024 + (ob ^ (((ob >> 9) & 1) << 5)); }
__host__ __device__ __forceinline__ void stage_rc(int b, int& R, int& C) { const int st = b / 1024, sb = b % 1024, swz = sb ^ (((sb >> 9) & 1) << 5); R = (st >> 1) * 16 + swz / 64; C = (st & 1) * 32 + (swz % 64) / 2; }
__host__ __device__ __forceinline__ int perm32(int rho) { const int n = rho >> 4, i = rho & 15; return 8 * (i >> 2) + 4 * n + (i & 3); }

struct Unit { int pm, pn; };
struct Gemm { const bf16_t* A; const bf16_t* Bt; int M, N, K; };

struct StaticOrder {
    int nM, nN, nwg, G, c;
    __host__ __device__ void init(int M, int N, int G_, int c_) { nM = M / BM; nN = N / BM; nwg = nM * nN; G = G_; c = c_; }
    __host__ __device__ bool next(int i, Unit& u) const {
        const long L = (long)i * G + c; if (L >= nwg) return false;
        int wgid = (int)L; { const int q = nwg / NXCD, r = nwg % NXCD, xcd = wgid % NXCD, off = wgid / NXCD; wgid = (xcd < r ? xcd * (q + 1) : r * (q + 1) + (xcd - r) * q) + off; }
        const int nig = WGM * nN, gid = wgid / nig, fm = gid * WGM, gsz = (nM - fm) < WGM ? (nM - fm) : WGM;
        u.pm = fm + ((wgid % nig) % gsz); u.pn = (wgid % nig) / gsz; return true;
    }
    __device__ __forceinline__ void a_ready(const Unit&) const {}
    __device__ __forceinline__ void done(const Unit&) const {}
};
typedef __bf16 bf16x2n_t __attribute__((ext_vector_type(2))); typedef float f32x2n_t __attribute__((ext_vector_type(2)));
__device__ __forceinline__ unsigned cvt_pk_bf16(float lo, float hi) { f32x2n_t v = {lo, hi}; bf16x2n_t r = __builtin_convertvector(v, bf16x2n_t); return __builtin_bit_cast(unsigned, r); }
template <class Epi, class Sched, bool STAMP = false>
__device__ __forceinline__ void gemm_phase(PG8_LAS unsigned char* lds, const Gemm g, const Sched& S, const Epi& E, unsigned long long* stamps) {
    int tid_ = threadIdx.x; asm volatile("" : "+v"(tid_));
    const int tid = tid_, wid = __builtin_amdgcn_readfirstlane(tid >> 6), lane = tid & 63, wr = wid >> 2, wc = wid & 3, fr = lane & 15, fq = lane >> 4;
    const int K = g.K, nt = K / BK;
    int ts_lo = 0, ts_hi = 0, nts = 0; const unsigned long long rt_entry = STAMP ? (unsigned long long)wall_clock64() : 0ull;
#define PG8_STAMP() do { if (STAMP && wid == 0 && nts < 64) { const unsigned long long _c = (unsigned long long)clock64(); \
        ts_lo = (lane == nts) ? (int)(unsigned)_c : ts_lo; ts_hi = (lane == nts) ? (int)(unsigned)(_c >> 32) : ts_hi; ++nts; } } while (0)
    PG8_STAMP();
    unsigned voffA[2], voffB[2];
#pragma unroll
    for (int i = 0; i < 2; ++i) { int R, C; stage_rc(tid * 16 + i * 8192, R, C); const int Rb = Epi::PERM ? ((R & ~31) + perm32(R & 31)) : R;
        voffA[i] = (unsigned)(R * K + C) * 2u; voffB[i] = (unsigned)(Rb * K + C) * 2u; }
    const size_t kstep = (size_t)(BK * 2);
    const size_t hstep = (size_t)HALF * K * 2;
    const size_t tstep = 2 * hstep;
    const unsigned ldsw = (unsigned)wid * 1024u;
    const int aoff = lds_byte(wr * 64 + fr, fq * 8), boff = lds_byte(wc * 32 + fr, fq * 8);
#define PG8_SA(b, h) (((b) * 2 + (h)) * HTB)
#define PG8_SB(b, h) ((4 + (b) * 2 + (h)) * HTB)
#define PG8_STAGE(bufoff, gbase, voff) do { _Pragma("unroll") for (int _i = 0; _i < 2; ++_i) \
        __builtin_amdgcn_global_load_lds((const unsigned*)((const char*)(gbase) + (voff)[_i]), (PG8_LAS unsigned*)(lds + (bufoff) + ldsw + _i * 8192), 16, 0, 0); } while (0)
#define PG8_LDA(dst, b, h) do { _Pragma("unroll") for (int m = 0; m < 4; ++m) _Pragma("unroll") for (int k = 0; k < 2; ++k) dst[m][k] = *(const PG8_LAS bf16x8*)(lds + PG8_SA(b, h) + aoff + m * 2048 + k * 1024); } while (0)
#define PG8_LDB(dst, b, h) do { _Pragma("unroll") for (int n = 0; n < 2; ++n) _Pragma("unroll") for (int k = 0; k < 2; ++k) dst[n][k] = *(const PG8_LAS bf16x8*)(lds + PG8_SB(b, h) + boff + n * 2048 + k * 1024); } while (0)
#define PG8_MMA(ai, bj, At, Bt) do { __builtin_amdgcn_s_setprio(1); _Pragma("unroll") for (int m = 0; m < 4; ++m) _Pragma("unroll") for (int n = 0; n < 2; ++n) _Pragma("unroll") for (int k = 0; k < 2; ++k) \
        acc[ai][bj][m][n] = __builtin_amdgcn_mfma_f32_16x16x32_bf16(Bt[n][k], At[m][k], acc[ai][bj][m][n], 0, 0, 0); __builtin_amdgcn_s_setprio(0); } while (0)
#define PG8_WAIT_V(n) asm volatile("s_waitcnt vmcnt(" #n ")" ::: "memory")
#define PG8_WAIT_L(n) asm volatile("s_waitcnt lgkmcnt(" #n ")" ::: "memory")
#define PG8_BAR __builtin_amdgcn_s_barrier()
#define PG8_SCHED __builtin_amdgcn_sched_barrier(0)
    Unit cur, nxt; int ui = 0;
    if (!S.next(0, cur)) return;
    f32x4 acc[2][2][4][2];
#pragma unroll
    for (int a = 0; a < 2; ++a)
#pragma unroll
        for (int b = 0; b < 2; ++b)
#pragma unroll
            for (int m = 0; m < 4; ++m)
#pragma unroll
                for (int n = 0; n < 2; ++n) acc[a][b][m][n] = (f32x4){0.f, 0.f, 0.f, 0.f};
    bf16x8 At[4][2], B0[2][2], B1[2][2];
    const char* cA = (const char*)g.A + (size_t)cur.pm * tstep; const char* cB = (const char*)g.Bt + (size_t)cur.pn * tstep;
    S.a_ready(cur);
    PG8_STAGE(PG8_SB(0, 0), cB, voffB); PG8_STAGE(PG8_SA(0, 0), cA, voffA); PG8_STAGE(PG8_SB(0, 1), cB + hstep, voffB); PG8_STAGE(PG8_SA(0, 1), cA + hstep, voffA);
    if (wr == 1) PG8_BAR;
    PG8_WAIT_V(4); PG8_BAR;
    PG8_STAGE(PG8_SB(1, 0), cB + kstep, voffB); PG8_STAGE(PG8_SA(1, 0), cA + kstep, voffA); PG8_STAGE(PG8_SB(1, 1), cB + hstep + kstep, voffB);
    PG8_WAIT_V(6); PG8_BAR;
    PG8_STAMP();
    for (;;) {
        const bool has_next = S.next(ui + 1, nxt);
        const char* nA = has_next ? (const char*)g.A + (size_t)nxt.pm * tstep : cA; const char* nB = has_next ? (const char*)g.Bt + (size_t)nxt.pn * tstep : cB;
        for (int t = 0; t < nt; t += 2) {
            const bool last = (t == nt - 2);
            const char* a1 = cA + (size_t)(t + 1) * kstep;
            const char* a2 = last ? nA : cA + (size_t)(t + 2) * kstep; const char* b2 = last ? nB : cB + (size_t)(t + 2) * kstep;
            const char* a3 = a2 + kstep; const char* b3 = b2 + kstep;
            if (last && has_next) S.a_ready(nxt);
            PG8_LDB(B0, 0, 0); PG8_SCHED; PG8_LDA(At, 0, 0); PG8_STAGE(PG8_SA(1, 1), a1 + hstep, voffA);
            PG8_WAIT_L(8); PG8_BAR; PG8_WAIT_L(0); PG8_MMA(0, 0, At, B0); PG8_BAR; PG8_SCHED;
            PG8_LDB(B1, 0, 1); PG8_STAGE(PG8_SB(0, 0), b2, voffB);
            PG8_BAR; PG8_WAIT_L(0); PG8_MMA(0, 1, At, B1); PG8_BAR;
            PG8_LDA(At, 0, 1); PG8_STAGE(PG8_SA(0, 0), a2, voffA);
            PG8_BAR; PG8_WAIT_L(0); PG8_MMA(1, 0, At, B0); PG8_BAR; PG8_SCHED;
            PG8_STAGE(PG8_SB(0, 1), b2 + hstep, voffB);
            PG8_WAIT_V(6); PG8_BAR; PG8_MMA(1, 1, At, B1); PG8_BAR;
            PG8_LDB(B0, 1, 0); PG8_SCHED; PG8_LDA(At, 1, 0); PG8_STAGE(PG8_SA(0, 1), a2 + hstep, voffA);
            PG8_WAIT_L(8); PG8_BAR; PG8_WAIT_L(0); PG8_MMA(0, 0, At, B0); PG8_BAR; PG8_SCHED;
            PG8_LDB(B1, 1, 1); PG8_STAGE(PG8_SB(1, 0), b3, voffB);
            PG8_BAR; PG8_WAIT_L(0); PG8_MMA(0, 1, At, B1); PG8_BAR;
            PG8_LDA(At, 1, 1); PG8_STAGE(PG8_SA(1, 0), a3, voffA);
            PG8_BAR; PG8_WAIT_L(0); PG8_MMA(1, 0, At, B0); PG8_BAR; PG8_SCHED;
            PG8_STAGE(PG8_SB(1, 1), b3 + hstep, voffB);
            PG8_WAIT_V(6); PG8_BAR; PG8_MMA(1, 1, At, B1); PG8_BAR;
        }
        PG8_STAMP();
        if constexpr (!Epi::AFTER_DRAIN) { E(acc, cur, wr, wc, fr, fq); S.done(cur); }
        PG8_STAMP();
        if (!has_next) break;
#pragma unroll
        for (int a = 0; a < 2; ++a)
#pragma unroll
            for (int b = 0; b < 2; ++b)
#pragma unroll
                for (int m = 0; m < 4; ++m)
#pragma unroll
                    for (int n = 0; n < 2; ++n) acc[a][b][m][n] = (f32x4){0.f, 0.f, 0.f, 0.f};
        cur = nxt; cA = nA; cB = nB; ++ui;
    }
    PG8_WAIT_V(0);
    if (wr == 0) PG8_BAR;
    PG8_BAR;
    if constexpr (Epi::AFTER_DRAIN) { E.fused(acc, cur, wr, wc, fr, fq, lds, wid, lane); S.done(cur); }
    PG8_STAMP();
    if (STAMP && wid == 0) { stamps[lane] = lane < nts ? (((unsigned long long)(unsigned)ts_hi << 32) | (unsigned)ts_lo) : 0ull;
        if (lane == 62) stamps[62] = rt_entry; if (lane == 63) stamps[63] = (unsigned long long)wall_clock64(); }
#undef PG8_STAMP
#undef PG8_SA
#undef PG8_SB
#undef PG8_STAGE
#undef PG8_LDA
#undef PG8_LDB
#undef PG8_MMA
#undef PG8_WAIT_V
#undef PG8_WAIT_L
#undef PG8_BAR
#undef PG8_SCHED
}
}
#define XB_TMO      128
#define XB_XCNT(j)  (256  + 64 * (j))
#define XB_XSUB(j)  (1280 + 64 * (j))
#define XB_XGEN(j)  (2304 + 64 * (j))
#define XB_TOP      3328
#define XB_TOPGEN   3392
#define XCD_BAR_WORDS 3456
#define XB_SPIN_CAP (1u << 18)
#define LAS __attribute__((address_space(3)))

__device__ __forceinline__ unsigned xb_ld(unsigned* p)              { return __hip_atomic_load(p, __ATOMIC_RELAXED, __HIP_MEMORY_SCOPE_AGENT); }
__device__ __forceinline__ unsigned xb_add(unsigned* p, unsigned v) { return __hip_atomic_fetch_add(p, v, __ATOMIC_RELAXED, __HIP_MEMORY_SCOPE_AGENT); }
__device__ __forceinline__ unsigned xb_xcc_id() { return (unsigned)__builtin_amdgcn_s_getreg((3 << 11) | 20) & 0xFu; }
#define XB_SPIN(cond, bar) do { unsigned _sp = 0; while (cond) { __builtin_amdgcn_s_sleep(1); \
    if ((++_sp & 255u) == 0u) { if (xb_ld(&(bar)[XB_TMO])) break; if (_sp > XB_SPIN_CAP) { atomicAdd(&(bar)[XB_TMO], 1u); break; } } } } while (0)

struct XcdBarrier {
    unsigned* bar; unsigned x;
    volatile LAS unsigned* st;
};

__device__ __forceinline__ XcdBarrier xcd_barrier_post(unsigned* bar, volatile LAS unsigned* st) {
    XcdBarrier b; b.bar = bar; b.x = xb_xcc_id(); b.st = st;
    if (threadIdx.x == 0) (void)xb_add(&bar[XB_XCNT(b.x)], 1u);
    return b;
}
__device__ __forceinline__ void xcd_barrier_complete(unsigned* bar, unsigned x, unsigned& nloc, unsigned& nx) {
    const unsigned G = gridDim.x * gridDim.y * gridDim.z;
    unsigned sum, cnt, mine, sp = 0u;
    for (;;) {
        sum = 0u; cnt = 0u; mine = 0u;
#pragma unroll
        for (unsigned j = 0; j < 16; ++j) { const unsigned c = xb_ld(&bar[XB_XCNT(j)]); sum += c; cnt += (c > 0u) ? 1u : 0u; mine = (j == x) ? c : mine; }
        if (sum == G) break;
        __builtin_amdgcn_s_sleep(1);
        if ((++sp & 255u) == 0u) { if (xb_ld(&bar[XB_TMO])) break; if (sp > XB_SPIN_CAP) { atomicAdd(&bar[XB_TMO], 1u); break; } }
    }
    nloc = mine > 0u ? mine : 1u; nx = cnt > 0u ? cnt : 1u;
}

__device__ __forceinline__ void xcd_barrier(const XcdBarrier& b) {
    asm volatile("s_waitcnt vmcnt(0)" ::: "memory");
    __syncthreads();
    if (threadIdx.x == 0) {
        unsigned* bar = b.bar;
        __builtin_amdgcn_s_waitcnt(0);
        unsigned nloc = b.st[0], nx = b.st[1];
        if (nloc == 0u) { xcd_barrier_complete(bar, b.x, nloc, nx); b.st[0] = nloc; b.st[1] = nx; }
        const unsigned old = xb_add(&bar[XB_XSUB(b.x)], 1u);
        const unsigned gen = old / nloc;
        if (old + 1u == (gen + 1u) * nloc) {
            __builtin_amdgcn_fence(__ATOMIC_RELEASE, "agent");
            asm volatile("s_waitcnt vmcnt(0)" ::: "memory");
            const unsigned og = xb_add(&bar[XB_TOP], 1u);
            const unsigned tg = og / nx;
            __builtin_amdgcn_fence(__ATOMIC_ACQUIRE, "agent");
            if (og + 1u == (tg + 1u) * nx) xb_add(&bar[XB_TOPGEN], 1u);
            else XB_SPIN(xb_ld(&bar[XB_TOPGEN]) == tg, bar);
            asm volatile("" ::: "memory");
            xb_add(&bar[XB_XGEN(b.x)], 1u);
            asm volatile("s_waitcnt vmcnt(0)" ::: "memory");
        } else {
            __builtin_amdgcn_fence(__ATOMIC_ACQUIRE, "agent");
            XB_SPIN(xb_ld(&bar[XB_XGEN(b.x)]) == gen, bar);
            asm volatile("s_waitcnt vmcnt(0)" ::: "memory");
        }
    }
    __syncthreads();
}


using pg8::bf16x8; using pg8::f32x4; using pg8::u32x4;
typedef unsigned short bf16_t;
typedef unsigned u32x2 __attribute__((ext_vector_type(2)));
typedef float f32x2v __attribute__((ext_vector_type(2)));

struct Params { const float* in[34]; float* out; unsigned char* ws; };

constexpr int NTOK = 12288;
constexpr size_t OFF_WT0 = 0, OFF_WO0 = 13107200, OFF_WT1 = 17301504, OFF_WO1 = 29884416, OFF_H = 34078720, OFF_P = 59244544,
                 OFF_YC = 210239488, OFF_DT = 260571136, OFF_MODS = 263716864, OFF_POSR = 263938048, OFF_POSC = 263970816, OFF_DEC = 264101888, OFF_BAR = 264114176;
constexpr size_t OUT_STF = 12582912, OUT_STB = 14680064;
constexpr float ALPHA_C = 1.41421356237f;
constexpr int LDP = 136;

__device__ __forceinline__ float bf2f(unsigned short b) { return __uint_as_float(((unsigned)b) << 16); }
__device__ __forceinline__ float bflo(unsigned u) { return __uint_as_float(u << 16); }
__device__ __forceinline__ float bfhi(unsigned u) { return __uint_as_float(u & 0xffff0000u); }
__device__ __forceinline__ unsigned pk2(float lo, float hi) { return pg8::cvt_pk_bf16(lo, hi); }
__device__ __forceinline__ float silu_f(float x) { return x * __builtin_amdgcn_rcpf(1.f + __expf(-x)); }
__device__ __forceinline__ float sigmoid_f(float x) { return __builtin_amdgcn_rcpf(1.f + __expf(-x)); }
__device__ __forceinline__ int swz(int r, int j) { return r * LDP + ((((j >> 3) ^ (r >> 3)) & 15) << 3) + (j & 7); }
__device__ __forceinline__ float softplus_f(float x) { return x > 20.f ? x : log1pf(expf(x)); }
__device__ __forceinline__ f32x4 mfma16(bf16x8 a, bf16x8 b, f32x4 c) { return __builtin_amdgcn_mfma_f32_16x16x32_bf16(a, b, c, 0, 0, 0); }
__device__ __forceinline__ void unpack8(u32x4 v, float (&o)[8]) { o[0] = bflo(v.x); o[1] = bfhi(v.x); o[2] = bflo(v.y); o[3] = bfhi(v.y); o[4] = bflo(v.z); o[5] = bfhi(v.z); o[6] = bflo(v.w); o[7] = bfhi(v.w); }
__device__ __forceinline__ int opaque_tid() { int t = threadIdx.x; asm volatile("" : "+v"(t)); return t; }
__device__ __forceinline__ int cond_of_row(int r) { return r < 4096 ? 0 : 1 + ((r - 4096) >> 10); }

template <int WHICH> __device__ __forceinline__ void tr_load(const float* __restrict__ src, int tt, int tid, f32x4 (&v)[4]) {
    constexpr int K = (WHICH == 0 || WHICH == 2) ? 1024 : 2048, Nsrc = WHICH == 0 ? 6176 : (WHICH == 2 ? 6144 : 1024), nkt = K / 64;
    const int ntile = tt / nkt, ktile = tt % nkt;
#pragma unroll
    for (int i = 0; i < 4; ++i) { const int idx = tid + 512 * i, k = idx >> 5, nd = ntile * 128 + (idx & 31) * 4; int ns = nd; bool ok = true;
        if (WHICH == 0) { if (nd < 3072) ns = nd; else if (nd < 5120) { const int t = (nd - 3072) >> 8, lc = (nd - 3072) & 255; ns = lc < 128 ? 3104 + 128 * t + lc : 4128 + 128 * t + (lc - 128); } else if (nd < 6144) ns = nd + 32; else if (nd < 6176) ns = nd - 3072; else { ok = false; ns = 0; } }
        const f32x4 x = *(const f32x4*)(src + (size_t)(ktile * 64 + k) * Nsrc + ns); v[i] = ok ? x : (f32x4){0.f, 0.f, 0.f, 0.f}; }
}
template <int WHICH> __device__ __forceinline__ void transpose_tiles(const float* __restrict__ src, bf16_t* __restrict__ dst, float* tile, int bidx, int nb) {
    constexpr int K = (WHICH == 0 || WHICH == 2) ? 1024 : 2048, Nsrc = WHICH == 0 ? 6176 : (WHICH == 2 ? 6144 : 1024), Ndst = WHICH == 0 ? 6400 : Nsrc;
    constexpr int nkt = K / 64, ntiles = (Ndst / 128) * nkt;
    const int tid = opaque_tid();
    f32x4 cur[4];
    if (bidx < ntiles) tr_load<WHICH>(src, bidx, tid, cur);
    for (int tt = bidx; tt < ntiles; tt += nb) {
        const int ntile = tt / nkt, ktile = tt % nkt;
#pragma unroll
        for (int i = 0; i < 4; ++i) { const int idx = tid + 512 * i; float* tp = tile + (idx >> 5) * 129 + (idx & 31) * 4; tp[0] = cur[i][0]; tp[1] = cur[i][1]; tp[2] = cur[i][2]; tp[3] = cur[i][3]; }
        __syncthreads();
        if (tt + nb < ntiles) tr_load<WHICH>(src, tt + nb, tid, cur);
#pragma unroll
        for (int i = 0; i < 2; ++i) { const int idx = tid + 512 * i, n = idx >> 3, k8 = (idx & 7) * 8;
          const float e0 = tile[(k8 + 0) * 129 + n], e1 = tile[(k8 + 1) * 129 + n], e2 = tile[(k8 + 2) * 129 + n], e3 = tile[(k8 + 3) * 129 + n];
          const float e4 = tile[(k8 + 4) * 129 + n], e5 = tile[(k8 + 5) * 129 + n], e6 = tile[(k8 + 6) * 129 + n], e7 = tile[(k8 + 7) * 129 + n];
          u32x4 o; o.x = pk2(e0, e1); o.y = pk2(e2, e3); o.z = pk2(e4, e5); o.w = pk2(e6, e7);
          *(u32x4*)(dst + (size_t)(ntile * 128 + n) * K + ktile * 64 + k8) = o; }
        __syncthreads();
    }
}
__device__ __forceinline__ void phase_prep(const Params& p, unsigned char* smem) {
    float* sc = (float*)smem;
    float* red = sc + 9 * 1024;
    float* MODS = (float*)(p.ws + OFF_MODS);
    const int tid = opaque_tid();
    bool filled = false;
    for (int u = blockIdx.x; u < 192; u += gridDim.x) {
        if (!filled) {
            for (int e = tid; e < 9 * 1024; e += 512) { const int j = e >> 10, k = e & 1023; const float v = (j == 0) ? p.in[5][k] : p.in[4][(j - 1) * 1024 + k]; sc[e] = silu_f(v); }
            __syncthreads(); filled = true;
        }
        const int layer = u / 96, cb = u % 96;
        const float* W = p.in[layer ? 24 : 6]; const float* bias = p.in[layer ? 25 : 7];
        const int col = cb * 32 + (tid & 31), kg = tid >> 5;
        float acc[9];
#pragma unroll
        for (int j = 0; j < 9; ++j) acc[j] = 0.f;
#pragma unroll 16
        for (int kk = 0; kk < 64; ++kk) { const int k = kg * 64 + kk; const float w = W[(size_t)k * 3072 + col];
#pragma unroll
            for (int j = 0; j < 9; ++j) acc[j] = fmaf(sc[j * 1024 + k], w, acc[j]); }
#pragma unroll
        for (int j = 0; j < 9; ++j) red[(kg * 9 + j) * 32 + (tid & 31)] = acc[j];
        __syncthreads();
        if (tid < 288) { const int j = tid >> 5, c = tid & 31; float s = 0.f;
#pragma unroll
            for (int k2 = 0; k2 < 16; ++k2) s += red[(k2 * 9 + j) * 32 + c];
            MODS[(layer * 9 + j) * 3072 + cb * 32 + c] = s + bias[cb * 32 + c]; }
        __syncthreads();
    }
    __syncthreads();
    { float* tile = (float*)smem;
      const int G = gridDim.x, b = blockIdx.x;
      transpose_tiles<0>(p.in[8], (bf16_t*)(p.ws + OFF_WT0), tile, b, G);
      transpose_tiles<1>(p.in[21], (bf16_t*)(p.ws + OFF_WO0), tile, b, G);
      if (G != 256) {
          transpose_tiles<2>(p.in[26], (bf16_t*)(p.ws + OFF_WT1), tile, b, G);
          transpose_tiles<3>(p.in[31], (bf16_t*)(p.ws + OFF_WO1), tile, b, G); } }
    float* POSR = (float*)(p.ws + OFF_POSR); float* POSC = (float*)(p.ws + OFF_POSC);
    for (int e = blockIdx.x * 512 + tid; e < 80 * 512; e += gridDim.x * 512) {
        const int pos = e >> 9, d = e & 511, i = d & 255;
        const float freq = exp2f(-(float)i * (13.287712379549449f / 256.f));
        const float arg = (float)(pos < 16 ? pos : pos - 16) * freq;
        const float v = d < 256 ? sinf(arg) : cosf(arg);
        if (pos < 16) POSR[pos * 512 + d] = v; else POSC[(pos - 16) * 512 + d] = v;
    }
}

__device__ __forceinline__ void phase_conv_h0(const Params& p, unsigned char* smem) {
    const int tid = opaque_tid();
    const float* MODS = (const float*)(p.ws + OFF_MODS); const float* POSR = (const float*)(p.ws + OFF_POSR); const float* POSC = (const float*)(p.ws + OFF_POSC);
    bf16_t* H = (bf16_t*)(p.ws + OFF_H);
    const int wave = tid >> 6, lane = tid & 63;
    for (int rb = (blockIdx.x * 8 + wave) * 3; rb < NTOK; rb += gridDim.x * 24) {
        f32x4 xv[3][4], pe[3][4];
#pragma unroll
        for (int k = 0; k < 3; ++k) { const int r = rb + k; const float* xr = r < 4096 ? p.in[0] + (size_t)r * 1024 : p.in[1] + (size_t)(r - 4096) * 1024; const int l = (r - 4096) & 1023;
#pragma unroll
            for (int i = 0; i < 4; ++i) { const int c = lane * 4 + 256 * i; xv[k][i] = *(const f32x4*)(xr + c); pe[k][i] = (f32x4){0.f, 0.f, 0.f, 0.f};
                if (r >= 4096) pe[k][i] = *(const f32x4*)(c < 512 ? POSR + (l >> 6) * 512 + c : POSC + (l & 63) * 512 + (c - 512)); } }
#pragma unroll
        for (int k = 0; k < 3; ++k) { const int r = rb + k; const int cond = cond_of_row(r); const float* shift = MODS + cond * 3072; const float* scale = shift + 1024;
#pragma unroll
            for (int i = 0; i < 4; ++i) { const int c = lane * 4 + 256 * i; const f32x4 sc = *(const f32x4*)(scale + c), sh = *(const f32x4*)(shift + c);
                const f32x4 h = (xv[k][i] + pe[k][i]) * (sc + 1.0f) + sh;
                u32x2 o; o.x = pk2(h[0], h[1]); o.y = pk2(h[2], h[3]); *(u32x2*)(H + (size_t)r * 1024 + c) = o; } }
    }
}

struct EpiIn {
    static constexpr bool PERM = true, AFTER_DRAIN = false;
    bf16_t* P; float* DT; float* LNP;
    __device__ __forceinline__ void operator()(const f32x4 (&acc)[2][2][4][2], const pg8::Unit& u, int wr, int wc, int fr, int fq) const {
        const int row0 = u.pm * 256 + wr * 64 + fr;
        const bool l0 = LNP == nullptr;
        if (l0 && u.pn >= 12 && u.pn < 20) {
            const int col0 = 3072 + (u.pn - 12) * 128 + wc * 32 + 8 * fq;
#pragma unroll
            for (int ai = 0; ai < 2; ++ai)
#pragma unroll
                for (int m = 0; m < 4; ++m) { const f32x4 v0 = acc[ai][0][m][0], v1 = acc[ai][0][m][1], g0 = acc[ai][1][m][0], g1 = acc[ai][1][m][1];
                    u32x4 w; w.x = pk2(v0[0] * sigmoid_f(g0[0]), v0[1] * sigmoid_f(g0[1])); w.y = pk2(v0[2] * sigmoid_f(g0[2]), v0[3] * sigmoid_f(g0[3]));
                    w.z = pk2(v1[0] * sigmoid_f(g1[0]), v1[1] * sigmoid_f(g1[1])); w.w = pk2(v1[2] * sigmoid_f(g1[2]), v1[3] * sigmoid_f(g1[3]));
                    *(u32x4*)(P + (size_t)(row0 + ai * 128 + m * 16) * 6144 + col0) = w; }
        } else if (u.pn < 24) {
            const int col0 = u.pn * 256 + wc * 32 + 8 * fq;
            const bool act = l0 ? (u.pn < 4 || u.pn >= 20) : (u.pn >= 16);
#pragma unroll
            for (int ai = 0; ai < 2; ++ai)
#pragma unroll
                for (int m = 0; m < 4; ++m) { bf16_t* rowp = P + (size_t)(row0 + ai * 128 + m * 16) * 6144 + col0;
#pragma unroll
                    for (int bj = 0; bj < 2; ++bj) { f32x4 v0 = acc[ai][bj][m][0], v1 = acc[ai][bj][m][1];
                        if (act) {
#pragma unroll
                            for (int e = 0; e < 4; ++e) { v0[e] = silu_f(v0[e]); v1[e] = silu_f(v1[e]); } }
                        u32x4 w; w.x = pk2(v0[0], v0[1]); w.y = pk2(v0[2], v0[3]); w.z = pk2(v1[0], v1[1]); w.w = pk2(v1[2], v1[3]);
                        *(u32x4*)(rowp + bj * 128) = w; } }
            if (!l0 && u.pn >= 8 && u.pn < 16) {
#pragma unroll
                for (int ai = 0; ai < 2; ++ai)
#pragma unroll
                    for (int m = 0; m < 4; ++m) { float s1 = 0.f, s2 = 0.f;
#pragma unroll
                        for (int bj = 0; bj < 2; ++bj)
#pragma unroll
                            for (int n = 0; n < 2; ++n)
#pragma unroll
                                for (int e = 0; e < 4; ++e) { const float v = acc[ai][bj][m][n][e]; s1 += v; s2 = fmaf(v, v, s2); }
                        s1 += __shfl_xor(s1, 16); s2 += __shfl_xor(s2, 16); s1 += __shfl_xor(s1, 32); s2 += __shfl_xor(s2, 32);
                        if (fq == 0) { f32x2v o; o.x = s1; o.y = s2; *(f32x2v*)(LNP + ((size_t)(row0 + ai * 128 + m * 16) * 32 + (u.pn - 8) * 4 + wc) * 2) = o; } }
            }
        } else if (wc == 0) {
#pragma unroll
            for (int ai = 0; ai < 2; ++ai)
#pragma unroll
                for (int m = 0; m < 4; ++m) { float* rowp = DT + (size_t)(row0 + ai * 128 + m * 16) * 32 + 8 * fq;
                    *(f32x4*)rowp = acc[ai][0][m][0]; *(f32x4*)(rowp + 4) = acc[ai][0][m][1]; }
        }
    }
};
struct EpiOut {
    static constexpr bool PERM = true, AFTER_DRAIN = false;
    bf16_t* Y; const float* gate;
    __device__ __forceinline__ void operator()(const f32x4 (&acc)[2][2][4][2], const pg8::Unit& u, int wr, int wc, int fr, int fq) const {
        const int row0 = u.pm * 256 + wr * 64 + fr, col0 = u.pn * 256 + wc * 32 + 8 * fq;
        const int cond = u.pm < 16 ? 0 : 1 + ((u.pm - 16) >> 2);
        f32x4 gv[2][2];
#pragma unroll
        for (int bj = 0; bj < 2; ++bj)
#pragma unroll
            for (int n = 0; n < 2; ++n) gv[bj][n] = *(const f32x4*)(gate + cond * 3072 + col0 + bj * 128 + n * 4);
#pragma unroll
        for (int ai = 0; ai < 2; ++ai)
#pragma unroll
            for (int m = 0; m < 4; ++m) { bf16_t* rowp = Y + (size_t)(row0 + ai * 128 + m * 16) * 1024 + col0;
#pragma unroll
                for (int bj = 0; bj < 2; ++bj) { const f32x4 v0 = acc[ai][bj][m][0] * gv[bj][0], v1 = acc[ai][bj][m][1] * gv[bj][1];
                    u32x4 w; w.x = pk2(v0[0], v0[1]); w.y = pk2(v0[2], v0[3]); w.z = pk2(v1[0], v1[1]); w.w = pk2(v1[2], v1[3]);
                    *(u32x4*)(rowp + bj * 128) = w; } }
    }
};

__device__ __forceinline__ void conformer_unit(const Params& p, unsigned char* smem, int unit) {
    const int tid = opaque_tid(), row_base = unit * 16;
    int seq0, L; if (row_base < 4096) { seq0 = row_base & ~255; L = 256; } else { seq0 = 4096 + ((row_base - 4096) & ~1023); L = 1024; }
    const int t0 = row_base - seq0, c0 = tid * 2;
    const bf16_t* P = (const bf16_t*)(p.ws + OFF_P); bf16_t* YC = (bf16_t*)(p.ws + OFF_YC);
    float w[31][2];
#pragma unroll
    for (int k = 0; k < 31; ++k) { const f32x2v v = *(const f32x2v*)(p.in[17] + k * 1024 + c0); w[k][0] = v.x; w[k][1] = v.y; }
    float acc[16][2];
    { const f32x2v b = *(const f32x2v*)(p.in[18] + c0);
#pragma unroll
      for (int tt = 0; tt < 16; ++tt) { acc[tt][0] = b.x; acc[tt][1] = b.y; } }
    const bf16_t* Pv = P + 3072 + c0;
    unsigned gtv[16];
#pragma unroll
    for (int tt = 0; tt < 16; ++tt) gtv[tt] = *(const unsigned*)(P + (size_t)(row_base + tt) * 6144 + 5120 + c0);
    unsigned uraw[46];
#pragma unroll
    for (int jr = 0; jr < 46; ++jr) { const int t = t0 - 15 + jr, tc = t < 0 ? 0 : (t >= L ? L - 1 : t); uraw[jr] = *(const unsigned*)(Pv + (size_t)(seq0 + tc) * 6144); }
#pragma unroll
    for (int jr = 0; jr < 46; ++jr) {
        const int t = t0 - 15 + jr; const bool ok = t >= 0 && t < L; const float u0 = ok ? bflo(uraw[jr]) : 0.f, u1 = ok ? bfhi(uraw[jr]) : 0.f;
#pragma unroll
        for (int tt = 0; tt < 16; ++tt) { const int k = jr - tt; if (k >= 0 && k < 31) { acc[tt][0] = fmaf(w[k][0], u0, acc[tt][0]); acc[tt][1] = fmaf(w[k][1], u1, acc[tt][1]); } }
    }
    float* red1 = (float*)smem; float* red2 = red1 + 16 * 512; float* stat = red2 + 16 * 512;
#pragma unroll
    for (int tt = 0; tt < 16; ++tt) { red1[tt * 512 + tid] = acc[tt][0] + acc[tt][1]; red2[tt * 512 + tid] = acc[tt][0] * acc[tt][0] + acc[tt][1] * acc[tt][1]; }
    __syncthreads();
    { const int tt = tid >> 5, q = tid & 31; float s1 = 0.f, s2 = 0.f;
#pragma unroll
      for (int i = 0; i < 16; ++i) { s1 += red1[tt * 512 + q + 32 * i]; s2 += red2[tt * 512 + q + 32 * i]; }
#pragma unroll
      for (int o = 1; o < 32; o <<= 1) { s1 += __shfl_xor(s1, o); s2 += __shfl_xor(s2, o); }
      const float mean = s1 * (1.f / 1024.f), var = fmaxf(s2 * (1.f / 1024.f) - mean * mean, 0.f);
      if (q == 0) { stat[tt * 2] = mean; stat[tt * 2 + 1] = rsqrtf(var + 1e-5f); } }
    __syncthreads();
    const f32x2v lg = *(const f32x2v*)(p.in[19] + c0), lb = *(const f32x2v*)(p.in[20] + c0);
#pragma unroll
    for (int tt = 0; tt < 16; ++tt) {
        const int row = row_base + tt; const float mean = stat[tt * 2], rstd = stat[tt * 2 + 1];
        const unsigned gt = gtv[tt];
        float v0 = (acc[tt][0] - mean) * rstd * lg.x + lb.x, v1 = (acc[tt][1] - mean) * rstd * lg.y + lb.y;
        v0 = silu_f(v0) * bflo(gt); v1 = silu_f(v1) * bfhi(gt);
        *(unsigned*)(YC + (size_t)row * 2048 + 1024 + c0) = pk2(v0, v1);
    }
    __syncthreads();
}

struct DtRaw { float bias, alog, r0, r1; };
__device__ __forceinline__ DtRaw dt_load(const Params& p, int row0, int g, int tid) {
    const int wave = tid >> 6, lane = tid & 63, hh = wave >> 1, dir = wave & 1, h = g * 4 + hh;
    const float* DT = (const float*)(p.ws + OFF_DT) + (size_t)row0 * 32 + dir * 16 + h;
    DtRaw d; d.bias = p.in[dir ? 12 : 11][h]; d.alog = p.in[dir ? 14 : 13][h]; d.r0 = DT[(2 * lane) * 32]; d.r1 = DT[(2 * lane + 1) * 32]; return d;
}
__device__ __forceinline__ void dt_compute(const DtRaw& d, float* vdt, float* vcum, int tid, float* vw = nullptr) {
    const int wave = tid >> 6, lane = tid & 63, hh = wave >> 1, dir = wave & 1;
    const float a = -expf(d.alog);
    const float d0 = softplus_f(d.r0 + d.bias), d1 = softplus_f(d.r1 + d.bias);
    const float v0 = d0 * a, v1 = d1 * a, s = v0 + v1;
    float inc = s;
#pragma unroll
    for (int o = 1; o < 64; o <<= 1) { const float t = __shfl_up(inc, o); if (lane >= o) inc += t; }
    const float exc = inc - s, P0 = exc + v0;
    float* cd = vcum + (hh * 2 + dir) * 128; float* dd = vdt + (hh * 2 + dir) * 128;
    if (dir == 0) { cd[2 * lane] = P0; cd[2 * lane + 1] = inc; }
    else { const float total = __shfl(inc, 63); cd[2 * lane] = total - exc; cd[2 * lane + 1] = total - P0; }
    dd[2 * lane] = d0; dd[2 * lane + 1] = d1;
    if (vw != nullptr) {
        float* wd = vw + (hh * 2 + dir) * 128;
        if (dir == 0) { const float pe = __shfl(inc, (lane & ~7) | 7); wd[2 * lane] = __expf(pe - P0) * d0; wd[2 * lane + 1] = __expf(pe - inc) * d1; }
        else { const float total = __shfl(inc, 63), s0 = total - exc, s1 = total - P0, sb = __shfl(s0, lane & ~7); wd[2 * lane] = __expf(sb - s0) * d0; wd[2 * lane + 1] = __expf(sb - s1) * d1; }
    }
}
struct CwRaw { f32x4 w0, w1; float ad; };
__device__ __forceinline__ const float* conv_w_src(const Params& p, int g, int q) { const int k = q >> 7, c4 = (q & 127) * 4;
    const int gch = c4 < 256 ? g * 256 + c4 : (c4 < 384 ? 1024 + g * 128 + (c4 - 256) : 1536 + g * 128 + (c4 - 384));
    return k < 4 ? p.in[9] + k * 2048 + gch : p.in[10] + gch; }
__device__ __forceinline__ CwRaw conv_w_load(const Params& p, int g, int tid) {
    CwRaw r; r.w0 = *(const f32x4*)conv_w_src(p, g, tid); r.w1 = *(const f32x4*)conv_w_src(p, g, 512 + (tid & 127)); r.ad = p.in[15][g * 4 + (tid & 3)]; return r;
}
__device__ __forceinline__ void conv_w_store(const CwRaw& r, float* cwl, int tid) {
    *(f32x4*)(cwl + (tid >> 7) * 512 + (tid & 127) * 4) = r.w0;
    if (tid < 128) *(f32x4*)(cwl + 2048 + tid * 4) = r.w1;
    if (tid < 4) cwl[2560 + tid] = r.ad;
}
__device__ __forceinline__ void conv_load4(const bf16_t* P, int seq0, int L, int row0, int j0, int cc0, u32x4 (&raw)[7]) {
#pragma unroll
    for (int rr = 0; rr < 7; ++rr) { const int grow = row0 + j0 - 2 + rr, gc = grow < seq0 ? seq0 : (grow >= seq0 + L ? seq0 + L - 1 : grow);
        const u32x4 v = *(const u32x4*)(P + (size_t)gc * 6144 + 1024 + cc0); raw[rr] = (grow == gc) ? v : (u32x4){0u, 0u, 0u, 0u}; }
}
__device__ __forceinline__ void conv_compute4(const float* cwl, int lc0, const u32x4 (&raw)[7], float (&out)[4][8]) {
    float w[4][8], b[8];
#pragma unroll
    for (int k = 0; k < 4; ++k) { const f32x4 a = *(const f32x4*)(cwl + k * 512 + lc0), c = *(const f32x4*)(cwl + k * 512 + lc0 + 4);
        w[k][0] = a[0]; w[k][1] = a[1]; w[k][2] = a[2]; w[k][3] = a[3]; w[k][4] = c[0]; w[k][5] = c[1]; w[k][6] = c[2]; w[k][7] = c[3]; }
    { const f32x4 a = *(const f32x4*)(cwl + 2048 + lc0), c = *(const f32x4*)(cwl + 2048 + lc0 + 4); b[0] = a[0]; b[1] = a[1]; b[2] = a[2]; b[3] = a[3]; b[4] = c[0]; b[5] = c[1]; b[6] = c[2]; b[7] = c[3]; }
#pragma unroll
    for (int jj = 0; jj < 4; ++jj) {
        float a[8];
#pragma unroll
        for (int e = 0; e < 8; ++e) a[e] = b[e];
#pragma unroll
        for (int k = 0; k < 4; ++k) { float x[8]; unpack8(raw[jj + k], x);
#pragma unroll
            for (int e = 0; e < 8; ++e) a[e] = fmaf(w[k][e], x[e], a[e]); }
#pragma unroll
        for (int e = 0; e < 8; ++e) out[jj][e] = silu_f(a[e]);
    }
}
__device__ __forceinline__ void seq_of_row(int row0, int& seq0, int& L) { if (row0 < 4096) { seq0 = row0 & ~255; L = 256; } else { seq0 = 4096 + ((row0 - 4096) & ~1023); L = 1024; } }

__device__ __forceinline__ void sstate_unit(const Params& p, unsigned char* smem, int unit) {
    const int tid = opaque_tid(), wave = tid >> 6, lane = tid & 63, fr = lane & 15, fq = lane >> 4;
    const int cgi = unit >> 2, g = unit & 3, row0 = cgi * 128; int seq0, L; seq_of_row(row0, seq0, L);
    const bf16_t* P = (const bf16_t*)(p.ws + OFF_P); bf16_t* SST = (bf16_t*)p.out; float* DEC = (float*)(p.ws + OFF_DEC);
    bf16_t* BT = (bf16_t*)smem; bf16_t* XTf = BT + 128 * LDP; bf16_t* XTb = XTf + 128 * LDP; float* vdt = (float*)(smem + 104448); float* vcum = (float*)(smem + 108544);
    float* cwl = (float*)(smem + 112640);
    const int chl = (tid & 15) * 8, j0 = (tid >> 4) * 4;
    u32x4 rawB[7], rawX[7], rawC[7];
    bf16_t* CVX = (bf16_t*)(p.ws + OFF_P) + 4096 + g * 256; bf16_t* CVBC = (bf16_t*)(p.ws + OFF_H) + g * 128;
    const DtRaw dtr = dt_load(p, row0, g, tid);
    const CwRaw cwr = conv_w_load(p, g, tid);
    conv_load4(P, seq0, L, row0, j0, 1024 + g * 128 + chl, rawB);
    conv_load4(P, seq0, L, row0, j0, 1536 + g * 128 + chl, rawC);
    conv_load4(P, seq0, L, row0, j0, g * 256 + chl, rawX);
    conv_w_store(cwr, cwl, tid);
    dt_compute(dtr, vdt, vcum, tid);
    __syncthreads();
    if (tid < 8) { const int hh = tid >> 1, dir = tid & 1; DEC[(cgi * 16 + g * 4 + hh) * 2 + dir] = expf(dir == 0 ? vcum[(hh * 2) * 128 + 127] : vcum[(hh * 2 + 1) * 128]); }
#pragma unroll
    for (int pair = 0; pair < 2; ++pair) {
        if (pair) __syncthreads();
#ifdef DUP_SCONV
#pragma unroll 1
        for (int rep_ = 0; rep_ < 2; ++rep_) { asm volatile("" ::: "memory");
#endif
        { if (pair == 0) {
              float o[4][8]; conv_compute4(cwl, 256 + chl, rawB, o);
#pragma unroll
              for (int e = 0; e < 8; ++e) { u32x2 a; a.x = pk2(o[0][e], o[1][e]); a.y = pk2(o[2][e], o[3][e]); *(u32x2*)(BT + swz(chl + e, j0)) = a; }
#pragma unroll
              for (int jj = 0; jj < 4; ++jj) { u32x4 a; a.x = pk2(o[jj][0], o[jj][1]); a.y = pk2(o[jj][2], o[jj][3]); a.z = pk2(o[jj][4], o[jj][5]); a.w = pk2(o[jj][6], o[jj][7]);
                  *(u32x4*)(CVBC + (size_t)(row0 + j0 + jj) * 1024 + chl) = a; }
              conv_compute4(cwl, 384 + chl, rawC, o);
#pragma unroll
              for (int jj = 0; jj < 4; ++jj) { u32x4 a; a.x = pk2(o[jj][0], o[jj][1]); a.y = pk2(o[jj][2], o[jj][3]); a.z = pk2(o[jj][4], o[jj][5]); a.w = pk2(o[jj][6], o[jj][7]);
                  *(u32x4*)(CVBC + (size_t)(row0 + j0 + jj) * 1024 + 512 + chl) = a; }
          }
          const int hh = pair * 2 + (chl >> 6);
          float o[4][8]; conv_compute4(cwl, pair * 128 + chl, rawX, o);
#pragma unroll
          for (int jj = 0; jj < 4; ++jj) { u32x4 a; a.x = pk2(o[jj][0], o[jj][1]); a.y = pk2(o[jj][2], o[jj][3]); a.z = pk2(o[jj][4], o[jj][5]); a.w = pk2(o[jj][6], o[jj][7]);
              *(u32x4*)(CVX + (size_t)(row0 + j0 + jj) * 6144 + pair * 128 + chl) = a; }
          float wf[4], wb[4]; const float pf127 = vcum[(hh * 2) * 128 + 127], sb0 = vcum[(hh * 2 + 1) * 128];
#pragma unroll
          for (int jj = 0; jj < 4; ++jj) { wf[jj] = vdt[(hh * 2) * 128 + j0 + jj] * __expf(pf127 - vcum[(hh * 2) * 128 + j0 + jj]); wb[jj] = vdt[(hh * 2 + 1) * 128 + j0 + jj] * __expf(sb0 - vcum[(hh * 2 + 1) * 128 + j0 + jj]); }
#pragma unroll
          for (int e = 0; e < 8; ++e) { u32x2 a, c;
              a.x = pk2(o[0][e] * wf[0], o[1][e] * wf[1]); a.y = pk2(o[2][e] * wf[2], o[3][e] * wf[3]);
              c.x = pk2(o[0][e] * wb[0], o[1][e] * wb[1]); c.y = pk2(o[2][e] * wb[2], o[3][e] * wb[3]);
              *(u32x2*)(XTf + swz(chl + e, j0)) = a; *(u32x2*)(XTb + swz(chl + e, j0)) = c; }
        }
#ifdef DUP_SCONV
        }
#endif
        __syncthreads();
        if (pair == 0) conv_load4(P, seq0, L, row0, j0, g * 256 + 128 + chl, rawX);
        const int hd = wave >> 1, hl = hd >> 1, dir = hd & 1, nhalf = wave & 1;
        const bf16_t* XT = (dir ? XTb : XTf);
        f32x4 acc[4][4];
#pragma unroll
        for (int m = 0; m < 4; ++m)
#pragma unroll
            for (int nt = 0; nt < 4; ++nt) acc[m][nt] = (f32x4){0.f, 0.f, 0.f, 0.f};
#pragma unroll
        for (int ks = 0; ks < 4; ++ks) { bf16x8 a[4], b[4];
#pragma unroll
            for (int m = 0; m < 4; ++m) a[m] = *(const bf16x8*)(XT + swz(hl * 64 + m * 16 + fr, ks * 32 + fq * 8));
#pragma unroll
            for (int nt = 0; nt < 4; ++nt) b[nt] = *(const bf16x8*)(BT + swz(nhalf * 64 + nt * 16 + fr, ks * 32 + fq * 8));
#pragma unroll
            for (int m = 0; m < 4; ++m)
#pragma unroll
                for (int nt = 0; nt < 4; ++nt) acc[m][nt] = mfma16(b[nt], a[m], acc[m][nt]); }
        bf16_t* S = SST + ((size_t)(cgi * 16 + g * 4 + pair * 2 + hl) * 2 + dir) * 8192;
#pragma unroll
        for (int m = 0; m < 4; ++m)
#pragma unroll
            for (int nt = 0; nt < 4; ++nt) { u32x2 o; o.x = pk2(acc[m][nt][0], acc[m][nt][1]); o.y = pk2(acc[m][nt][2], acc[m][nt][3]);
                *(u32x2*)(S + (m * 16 + fr) * 128 + nhalf * 64 + nt * 16 + 4 * fq) = o; }
    }
    __syncthreads();
}


__device__ __forceinline__ void prefix_phase(const Params& p) {
    const int tid = opaque_tid();
    bf16_t* SST = (bf16_t*)p.out; const float* DEC = (const float*)(p.ws + OFF_DEC);
    for (int task = blockIdx.x; task < 1536; task += gridDim.x) {
        const int item = task >> 1, s = item >> 5, h = (item >> 1) & 15, dir = item & 1, e8 = ((task & 1) * 512 + tid) * 8;
        const int cg0 = s < 16 ? s * 2 : 32 + (s - 16) * 8, nc = s < 16 ? 2 : 8;
        float hv[8];
        if (s >= 16) { const float* h0 = p.in[dir ? 3 : 2] + (size_t)((s - 16) * 16 + h) * 8192 + e8; const f32x4 a = *(const f32x4*)h0, c = *(const f32x4*)(h0 + 4);
            hv[0] = a[0]; hv[1] = a[1]; hv[2] = a[2]; hv[3] = a[3]; hv[4] = c[0]; hv[5] = c[1]; hv[6] = c[2]; hv[7] = c[3]; }
        else {
#pragma unroll
            for (int e = 0; e < 8; ++e) hv[e] = 0.f; }
        u32x4 sv[8]; float dc[8];
#pragma unroll
        for (int k = 0; k < 8; ++k) { sv[k] = (u32x4){0u, 0u, 0u, 0u}; dc[k] = 0.f;
            if (k < nc) { const int c = dir ? nc - 1 - k : k; const size_t idx = (size_t)((cg0 + c) * 16 + h) * 2 + dir; sv[k] = *(const u32x4*)(SST + idx * 8192 + e8); dc[k] = DEC[idx]; } }
#pragma unroll
        for (int k = 0; k < 8; ++k) {
            if (k < nc) { const int c = dir ? nc - 1 - k : k; const size_t idx = (size_t)((cg0 + c) * 16 + h) * 2 + dir;
                u32x4 o; o.x = pk2(hv[0], hv[1]); o.y = pk2(hv[2], hv[3]); o.z = pk2(hv[4], hv[5]); o.w = pk2(hv[6], hv[7]);
                *(u32x4*)(SST + idx * 8192 + e8) = o;
                float x[8]; unpack8(sv[k], x);
#pragma unroll
                for (int e = 0; e < 8; ++e) hv[e] = fmaf(hv[e], dc[k], x[e]); } }
        if (s < 16) { float* o = p.out + (dir ? OUT_STB : OUT_STF) + (size_t)(s * 16 + h) * 8192 + e8;
            *(f32x4*)o = (f32x4){hv[0], hv[1], hv[2], hv[3]}; *(f32x4*)(o + 4) = (f32x4){hv[4], hv[5], hv[6], hv[7]}; }
    }
}

__device__ __forceinline__ void ssd_y_unit(const Params& p, unsigned char* smem, int unit) {
    const int tid = opaque_tid(), wave = tid >> 6, lane = tid & 63, fr = lane & 15, fq = lane >> 4;
    const int cgi = unit >> 2, g = unit & 3, row0 = cgi * 128; int seq0, L; seq_of_row(row0, seq0, L);
    const int cidx = (row0 - seq0) >> 7, nc = L >> 7, cg0 = seq0 >> 7; const bool is_sample = row0 >= 4096; const int bs = (row0 - 4096) >> 10;
    const bf16_t* P = (const bf16_t*)(p.ws + OFF_P); const bf16_t* SST = (const bf16_t*)p.out; const float* DEC = (const float*)(p.ws + OFF_DEC); bf16_t* YC = (bf16_t*)(p.ws + OFF_YC);
    bf16_t* Cs = (bf16_t*)smem; bf16_t* BM = Cs + 128 * LDP; bf16_t* XT = BM + 128 * LDP; bf16_t* Hf = XT + 64 * LDP; bf16_t* Hb = Hf + 64 * LDP;
    float* vdt = (float*)(smem + 121856); float* vcum = (float*)(smem + 125952);
    float* cwl = (float*)(smem + 130048);
    const bf16_t* CVX = (const bf16_t*)(p.ws + OFF_P) + 4096 + g * 256; const bf16_t* CVBC = (const bf16_t*)(p.ws + OFF_H) + g * 128;
    const int i = wave * 16 + fr;
    f32x4 cb[8];
#ifdef DUP_TOP
#pragma unroll 1
    for (int rep_ = 0; rep_ < 2; ++rep_) { asm volatile("" ::: "memory");
#endif
    { const int chl = (tid & 15) * 8, j0 = (tid >> 4) * 4;
      const DtRaw dtr = dt_load(p, row0, g, tid);
      const float adv = p.in[15][g * 4 + (tid & 3)];
      u32x4 cC[4], cB[4];
#pragma unroll
      for (int jj = 0; jj < 4; ++jj) { cC[jj] = *(const u32x4*)(CVBC + (size_t)(row0 + j0 + jj) * 1024 + 512 + chl); cB[jj] = *(const u32x4*)(CVBC + (size_t)(row0 + j0 + jj) * 1024 + chl); }
      if (tid < 4) cwl[2560 + tid] = adv;
      dt_compute(dtr, vdt, vcum, tid, cwl);
#pragma unroll
      for (int jj = 0; jj < 4; ++jj) { *(u32x4*)(Cs + (j0 + jj) * LDP + chl) = cC[jj]; *(u32x4*)(BM + (j0 + jj) * LDP + chl) = cB[jj]; } }
    __syncthreads();
#ifndef DUP_TOP
    float ssq = 0.f;
    const int grow = row0 + i; const int wave_u = __builtin_amdgcn_readfirstlane(wave);
    const int xchl = (tid & 15) * 4, xj0 = (tid >> 4) * 4;
    u32x4 hin[4]; u32x2 rawx[4]; u32x4 zz[2];
#define Y_LOAD_HEAD(HH) do { const int h_ = g * 4 + (HH); \
        _Pragma("unroll") for (int it = 0; it < 4; ++it) { const int v = tid + 512 * it, dir = v >> 10, e8 = (v & 1023) * 8; hin[it] = *(const u32x4*)(SST + ((size_t)(cgi * 16 + h_) * 2 + dir) * 8192 + e8); } \
        _Pragma("unroll") for (int jj = 0; jj < 4; ++jj) rawx[jj] = *(const u32x2*)(CVX + (size_t)(row0 + xj0 + jj) * 6144 + (HH) * 64 + xchl); \
        _Pragma("unroll") for (int t = 0; t < 2; ++t) zz[t] = *(const u32x4*)(P + (size_t)grow * 6144 + h_ * 64 + t * 32 + 8 * fq); } while (0)
    Y_LOAD_HEAD(0);
#endif
#pragma unroll
    for (int nt = 0; nt < 8; ++nt) cb[nt] = (f32x4){0.f, 0.f, 0.f, 0.f};
#pragma unroll
    for (int ks = 0; ks < 4; ++ks) { const bf16x8 a = *(const bf16x8*)(Cs + i * LDP + ks * 32 + fq * 8);
#pragma unroll
        for (int nt = 0; nt < 8; ++nt) { const bf16x8 b = *(const bf16x8*)(BM + (nt * 16 + fr) * LDP + ks * 32 + fq * 8); cb[nt] = mfma16(b, a, cb[nt]); } }
    __syncthreads();
#ifdef DUP_TOP
    }
#endif
#pragma unroll 1
    for (int hh = 0; hh < 4; ++hh) {
        const int h = g * 4 + hh;
        const float pfi = vcum[(hh * 2) * 128 + i], sbi = vcum[(hh * 2 + 1) * 128 + i];
#ifdef DUP_M
#pragma unroll 1
        for (int rep_ = 0; rep_ < 2; ++rep_) { asm volatile("" ::: "memory");
#endif
#pragma unroll
        for (int nt = 0; nt < 8; ++nt) { const int j0 = nt * 16 + 4 * fq; float mv[4];
            if (nt == wave_u) {
                const f32x4 pfj = *(const f32x4*)(vcum + (hh * 2) * 128 + j0), sbj = *(const f32x4*)(vcum + (hh * 2 + 1) * 128 + j0);
                const f32x4 dfj = *(const f32x4*)(vdt + (hh * 2) * 128 + j0), dbj = *(const f32x4*)(vdt + (hh * 2 + 1) * 128 + j0);
#pragma unroll
                for (int r = 0; r < 4; ++r) { const int j = j0 + r; const float arg = j < i ? pfi - pfj[r] : sbi - sbj[r]; const float ex = __expf(fminf(arg, 0.f));
                    const float m = j < i ? ex * dfj[r] : (j > i ? ex * dbj[r] : dfj[r] + dbj[r]); mv[r] = m * cb[nt][r]; }
            } else {
                const bool lower = nt < wave_u;
                const float e1 = __expf(fminf(lower ? pfi - vcum[(hh * 2) * 128 + nt * 16 + 15] : sbi - vcum[(hh * 2 + 1) * 128 + nt * 16], 0.f));
                const f32x4 wj = *(const f32x4*)(cwl + (hh * 2 + (lower ? 0 : 1)) * 128 + j0);
#pragma unroll
                for (int r = 0; r < 4; ++r) mv[r] = cb[nt][r] * (e1 * wj[r]);
            }
            u32x2 o; o.x = pk2(mv[0], mv[1]); o.y = pk2(mv[2], mv[3]);
            *(u32x2*)(BM + i * LDP + j0) = o; }
#ifdef DUP_M
        }
#endif
#ifdef DUP_STG
#pragma unroll 1
        for (int rep_ = 0; rep_ < 2; ++rep_) { asm volatile("" ::: "memory");
#endif
#pragma unroll
        for (int it = 0; it < 4; ++it) { const int v = tid + 512 * it, dir = v >> 10, e8 = (v & 1023) * 8, pp = e8 >> 7;
            const int rho = (pp & ~31) + 16 * ((pp >> 2) & 1) + 4 * ((pp & 31) >> 3) + (pp & 3);
            *(u32x4*)((dir ? Hb : Hf) + rho * LDP + (e8 & 127)) = hin[it]; }
        {
          u32x2 t0, t1, t2, t3;
          t0.x = __builtin_amdgcn_perm(rawx[1].x, rawx[0].x, 0x05040100u); t0.y = __builtin_amdgcn_perm(rawx[3].x, rawx[2].x, 0x05040100u);
          t1.x = __builtin_amdgcn_perm(rawx[1].x, rawx[0].x, 0x07060302u); t1.y = __builtin_amdgcn_perm(rawx[3].x, rawx[2].x, 0x07060302u);
          t2.x = __builtin_amdgcn_perm(rawx[1].y, rawx[0].y, 0x05040100u); t2.y = __builtin_amdgcn_perm(rawx[3].y, rawx[2].y, 0x05040100u);
          t3.x = __builtin_amdgcn_perm(rawx[1].y, rawx[0].y, 0x07060302u); t3.y = __builtin_amdgcn_perm(rawx[3].y, rawx[2].y, 0x07060302u);
          const int xr = (xchl & ~31) + 16 * ((xchl >> 2) & 1) + 4 * ((xchl & 31) >> 3);
          *(u32x2*)(XT + swz(xr + 0, xj0)) = t0; *(u32x2*)(XT + swz(xr + 1, xj0)) = t1; *(u32x2*)(XT + swz(xr + 2, xj0)) = t2; *(u32x2*)(XT + swz(xr + 3, xj0)) = t3; }
#ifdef DUP_STG
        }
#endif
        u32x4 zc[2];
#pragma unroll
        for (int t = 0; t < 2; ++t) zc[t] = zz[t];
        __syncthreads();
        if (hh < 3) Y_LOAD_HEAD(hh + 1);
#ifdef DUP_LD
        asm volatile("" ::: "memory"); if (hh < 3) Y_LOAD_HEAD(hh + 1);
#endif
        f32x4 yd[4], tf[4], tb[4];
#pragma unroll
        for (int nt = 0; nt < 4; ++nt) { yd[nt] = (f32x4){0.f, 0.f, 0.f, 0.f}; tf[nt] = yd[nt]; tb[nt] = yd[nt]; }
#ifdef DUP_MFMA
#pragma unroll 1
        for (int rep_ = 0; rep_ < 2; ++rep_) { asm volatile("" ::: "memory");
#endif
#pragma unroll 2
        for (int ks = 0; ks < 4; ++ks) { const bf16x8 am = *(const bf16x8*)(BM + i * LDP + ks * 32 + fq * 8), ac = *(const bf16x8*)(Cs + i * LDP + ks * 32 + fq * 8);
#pragma unroll
            for (int nt = 0; nt < 4; ++nt) { const int ro = (nt * 16 + fr) * LDP + ks * 32 + fq * 8;
                yd[nt] = mfma16(*(const bf16x8*)(XT + swz(nt * 16 + fr, ks * 32 + fq * 8)), am, yd[nt]); tf[nt] = mfma16(*(const bf16x8*)(Hf + ro), ac, tf[nt]); tb[nt] = mfma16(*(const bf16x8*)(Hb + ro), ac, tb[nt]); } }
#ifdef DUP_MFMA
        }
#pragma unroll
        for (int nt = 0; nt < 4; ++nt) { yd[nt] *= 0.5f; tf[nt] *= 0.5f; tb[nt] *= 0.5f; }
#endif
        const float ef = __expf(pfi), eb = __expf(sbi), ad = cwl[2560 + hh];
#ifdef DUP_COMB
        float ssq_keep = ssq;
#pragma unroll 1
        for (int rep_ = 0; rep_ < 2; ++rep_) { asm volatile("" ::: "memory"); if (rep_ == 1) ssq = ssq_keep;
#endif
#pragma unroll
        for (int t = 0; t < 2; ++t) { float zf[8]; unpack8(zc[t], zf); float yv[8];
#pragma unroll
            for (int n = 0; n < 2; ++n)
#pragma unroll
                for (int r = 0; r < 4; ++r) { const int nt = 2 * t + n; const float x = bf2f(XT[swz(nt * 16 + 4 * fq + r, i)]);
                    float y = yd[nt][r] + ef * tf[nt][r] + eb * tb[nt][r] + ad * x; y *= zf[4 * n + r]; ssq = fmaf(y, y, ssq); yv[4 * n + r] = y; }
            u32x4 o; o.x = pk2(yv[0], yv[1]); o.y = pk2(yv[2], yv[3]); o.z = pk2(yv[4], yv[5]); o.w = pk2(yv[6], yv[7]);
            *(u32x4*)(YC + (size_t)grow * 2048 + h * 64 + t * 32 + 8 * fq) = o; }
#ifdef DUP_COMB
        }
#endif
        __syncthreads();
    }
#undef Y_LOAD_HEAD
    ssq += __shfl_xor(ssq, 16); ssq += __shfl_xor(ssq, 32);
    const float rs = rsqrtf(ssq * (1.f / 256.f) + 1e-5f);
    { u32x4 yy[4][2]; f32x4 nwv[4][2][2];
#pragma unroll
      for (int hh = 0; hh < 4; ++hh)
#pragma unroll
          for (int t = 0; t < 2; ++t) { const int ch = g * 256 + hh * 64 + t * 32 + 8 * fq; yy[hh][t] = *(const u32x4*)(YC + (size_t)grow * 2048 + ch);
              nwv[hh][t][0] = *(const f32x4*)(p.in[16] + ch); nwv[hh][t][1] = *(const f32x4*)(p.in[16] + ch + 4); }
#pragma unroll
      for (int hh = 0; hh < 4; ++hh)
#pragma unroll
          for (int t = 0; t < 2; ++t) { const int ch = g * 256 + hh * 64 + t * 32 + 8 * fq; float yf[8]; unpack8(yy[hh][t], yf); const f32x4 n0 = nwv[hh][t][0], n1 = nwv[hh][t][1];
              u32x4 o; o.x = pk2(yf[0] * rs * n0[0], yf[1] * rs * n0[1]); o.y = pk2(yf[2] * rs * n0[2], yf[3] * rs * n0[3]); o.z = pk2(yf[4] * rs * n1[0], yf[5] * rs * n1[1]); o.w = pk2(yf[6] * rs * n1[2], yf[7] * rs * n1[3]);
              *(u32x4*)(YC + (size_t)grow * 2048 + ch) = o; } }
    __syncthreads();
}

__device__ __forceinline__ void gmlp_phase(const Params& p, unsigned char* smem) {
    const int tid = opaque_tid(), wave = tid >> 6, lane = tid & 63, fr = lane & 15, fq = lane >> 4;
    const int g = blockIdx.x & 15, cstep = gridDim.x >> 4;
    const bf16_t* P = (const bf16_t*)(p.ws + OFF_P); bf16_t* YC = (bf16_t*)(p.ws + OFF_YC); const float* LNP = (const float*)(p.ws + OFF_DT);
    bf16_t* Ws = (bf16_t*)smem; bf16_t* VT = Ws + 128 * LDP; float* stat = (float*)(smem + 69632);
    { const float* wsrc = p.in[29] + (size_t)g * 16384;
#pragma unroll
      for (int it = 0; it < 4; ++it) { const int bb = tid + 512 * it, row = bb >> 4, c8 = (bb & 15) * 8; const f32x4 a = *(const f32x4*)(wsrc + row * 128 + c8), c = *(const f32x4*)(wsrc + row * 128 + c8 + 4);
          u32x4 o; o.x = pk2(a[0], a[1]); o.y = pk2(a[2], a[3]); o.z = pk2(c[0], c[1]); o.w = pk2(c[2], c[3]); *(u32x4*)(Ws + row * LDP + c8) = o; } }
    const int d0 = (tid & 15) * 8, vj0 = (tid >> 4) * 4, vch = g * 128 + d0;
    const f32x4 ga = *(const f32x4*)(p.in[27] + vch), gb = *(const f32x4*)(p.in[27] + vch + 4), ba = *(const f32x4*)(p.in[28] + vch), bb = *(const f32x4*)(p.in[28] + vch + 4);
    const float gg[8] = {ga[0], ga[1], ga[2], ga[3], gb[0], gb[1], gb[2], gb[3]}, be[8] = {ba[0], ba[1], ba[2], ba[3], bb[0], bb[1], bb[2], bb[3]};
    const int i = wave * 16 + fr;
    const float bsi = p.in[30][g * 128 + i];
    f32x4 st[4]; u32x4 vr[4];
#define GM_LOAD(CG) do { const int r0_ = (CG) * 128; const float* lp = LNP + ((size_t)(r0_ + (tid >> 2)) * 32 + (tid & 3) * 8) * 2; \
        _Pragma("unroll") for (int k = 0; k < 4; ++k) st[k] = *(const f32x4*)(lp + 4 * k); \
        _Pragma("unroll") for (int jj = 0; jj < 4; ++jj) vr[jj] = *(const u32x4*)(P + (size_t)(r0_ + vj0 + jj) * 6144 + 2048 + vch); } while (0)
    if ((int)(blockIdx.x >> 4) < 96) GM_LOAD(blockIdx.x >> 4);
#pragma unroll 1
    for (int cgi = blockIdx.x >> 4; cgi < 96; cgi += cstep) {
        const int row0 = cgi * 128; const size_t grow = (size_t)(row0 + i);
        u32x4 uu[4], gt[4];
#pragma unroll
        for (int t = 0; t < 4; ++t) { const int ch = g * 128 + t * 32 + 8 * fq; uu[t] = *(const u32x4*)(P + grow * 6144 + ch); gt[t] = *(const u32x4*)(P + grow * 6144 + 4096 + ch); }
        { float s1 = st[0][0] + st[0][2] + st[1][0] + st[1][2] + st[2][0] + st[2][2] + st[3][0] + st[3][2], s2 = st[0][1] + st[0][3] + st[1][1] + st[1][3] + st[2][1] + st[2][3] + st[3][1] + st[3][3];
          s1 += __shfl_xor(s1, 1); s2 += __shfl_xor(s2, 1); s1 += __shfl_xor(s1, 2); s2 += __shfl_xor(s2, 2);
          const float mean = s1 * (1.f / 2048.f), var = fmaxf(s2 * (1.f / 2048.f) - mean * mean, 0.f);
          if ((tid & 3) == 0) { stat[(tid >> 2) * 2] = mean; stat[(tid >> 2) * 2 + 1] = rsqrtf(var + 1e-5f); } }
        __syncthreads();
        { float vn[4][8];
#pragma unroll
          for (int jj = 0; jj < 4; ++jj) { float x[8]; unpack8(vr[jj], x); const float mean = stat[(vj0 + jj) * 2], rstd = stat[(vj0 + jj) * 2 + 1];
#pragma unroll
              for (int e = 0; e < 8; ++e) vn[jj][e] = (x[e] - mean) * rstd * gg[e] + be[e]; }
#pragma unroll
          for (int e = 0; e < 8; ++e) { u32x2 o; o.x = pk2(vn[0][e], vn[1][e]); o.y = pk2(vn[2][e], vn[3][e]);
              const int rho = (d0 & ~31) + 16 * (e >> 2) + ((d0 & 31) >> 1) + (e & 3);
              *(u32x2*)(VT + swz(rho, vj0)) = o; } }
        __syncthreads();
        if (cgi + cstep < 96) GM_LOAD(cgi + cstep);
        f32x4 acc[8];
#pragma unroll
        for (int nt = 0; nt < 8; ++nt) acc[nt] = (f32x4){0.f, 0.f, 0.f, 0.f};
#pragma unroll
        for (int ks = 0; ks < 4; ++ks) { const bf16x8 a = *(const bf16x8*)(Ws + i * LDP + ks * 32 + fq * 8);
#pragma unroll
            for (int nt = 0; nt < 8; ++nt) acc[nt] = mfma16(*(const bf16x8*)(VT + swz(nt * 16 + fr, ks * 32 + fq * 8)), a, acc[nt]); }
#pragma unroll
        for (int t = 0; t < 4; ++t) { const int ch = g * 128 + t * 32 + 8 * fq; float uf[8], gf[8]; unpack8(uu[t], uf); unpack8(gt[t], gf);
            const f32x4 a0 = acc[2 * t], a1 = acc[2 * t + 1];
            u32x4 o; o.x = pk2(uf[0] * (a0[0] + bsi) * gf[0], uf[1] * (a0[1] + bsi) * gf[1]); o.y = pk2(uf[2] * (a0[2] + bsi) * gf[2], uf[3] * (a0[3] + bsi) * gf[3]);
            o.z = pk2(uf[4] * (a1[0] + bsi) * gf[4], uf[5] * (a1[1] + bsi) * gf[5]); o.w = pk2(uf[6] * (a1[2] + bsi) * gf[6], uf[7] * (a1[3] + bsi) * gf[7]);
            *(u32x4*)(YC + grow * 2048 + ch) = o; }
        __syncthreads();
    }
}

__device__ __forceinline__ void ln_phase(const Params& p, int layer) {
    const int tid = opaque_tid(), wave = tid >> 6, lane = tid & 63;
    const float* G = p.in[layer ? 32 : 22]; const float* B = p.in[layer ? 33 : 23];
    const float* MODS = (const float*)(p.ws + OFF_MODS) + 9 * 3072; bf16_t* H = (bf16_t*)(p.ws + OFF_H);
    const bf16_t* Yg = (const bf16_t*)(p.ws + OFF_P); const float* POSR = (const float*)(p.ws + OFF_POSR); const float* POSC = (const float*)(p.ws + OFF_POSC);
    for (int rb = (blockIdx.x * 8 + wave) * 3; rb < NTOK; rb += gridDim.x * 24) {
        f32x4 v[3][4]; u32x2 yv[3][4]; f32x4 pe[3][4];
#pragma unroll
        for (int k = 0; k < 3; ++k) { const int r = rb + k;
            const float* xr = layer ? p.out + (size_t)r * 1024 : (r < 4096 ? p.in[0] + (size_t)r * 1024 : p.in[1] + (size_t)(r - 4096) * 1024);
            const int l = (r - 4096) & 1023;
#pragma unroll
            for (int i = 0; i < 4; ++i) { const int c = lane * 4 + 256 * i; v[k][i] = *(const f32x4*)(xr + c); yv[k][i] = *(const u32x2*)(Yg + (size_t)r * 1024 + c);
                pe[k][i] = (f32x4){0.f, 0.f, 0.f, 0.f};
                if (layer == 0 && r >= 4096) pe[k][i] = *(const f32x4*)(c < 512 ? POSR + (l >> 6) * 512 + c : POSC + (l & 63) * 512 + (c - 512)); } }
#pragma unroll
        for (int k = 0; k < 3; ++k) { const int r = rb + k; float s = 0.f;
#pragma unroll
            for (int i = 0; i < 4; ++i) { const f32x4 y = (f32x4){bflo(yv[k][i].x), bfhi(yv[k][i].x), bflo(yv[k][i].y), bfhi(yv[k][i].y)};
                v[k][i] = (v[k][i] + pe[k][i]) * ALPHA_C + y; s += v[k][i][0] + v[k][i][1] + v[k][i][2] + v[k][i][3]; }
#pragma unroll
            for (int o = 1; o < 64; o <<= 1) s += __shfl_xor(s, o);
            const float mean = s * (1.f / 1024.f); float q = 0.f;
#pragma unroll
            for (int i = 0; i < 4; ++i) { v[k][i] -= mean; q += v[k][i][0] * v[k][i][0] + v[k][i][1] * v[k][i][1] + v[k][i][2] * v[k][i][2] + v[k][i][3] * v[k][i][3]; }
#pragma unroll
            for (int o = 1; o < 64; o <<= 1) q += __shfl_xor(q, o);
            const float rstd = rsqrtf(q * (1.f / 1024.f) + 1e-5f);
            const int cond = cond_of_row(r); float* xo = p.out + (size_t)r * 1024;
#pragma unroll
            for (int i = 0; i < 4; ++i) { const int c = lane * 4 + 256 * i; const f32x4 y = v[k][i] * rstd * *(const f32x4*)(G + c) + *(const f32x4*)(B + c);
                *(f32x4*)(xo + c) = y;
                if (layer == 0) { const f32x4 sh = *(const f32x4*)(MODS + cond * 3072 + c), sc = *(const f32x4*)(MODS + cond * 3072 + 1024 + c); const f32x4 h = y * (sc + 1.0f) + sh;
                    u32x2 o; o.x = pk2(h[0], h[1]); o.y = pk2(h[2], h[3]); *(u32x2*)(H + (size_t)r * 1024 + c) = o; } } }
    }
}

constexpr int NPHASE = 11;
template <int PH> __device__ __forceinline__ void run_phase(const Params& p, unsigned char* shm) {
    const bf16_t* H = (const bf16_t*)(p.ws + OFF_H); bf16_t* Pb = (bf16_t*)(p.ws + OFF_P); const bf16_t* YC = (const bf16_t*)(p.ws + OFF_YC);
    const float* MODS = (const float*)(p.ws + OFF_MODS);
    if constexpr (PH == 0) phase_prep(p, shm);
    if constexpr (PH == 1) phase_conv_h0(p, shm);
    if constexpr (PH == 2 || PH == 7) {
        pg8::Gemm g; g.A = H; g.Bt = (const bf16_t*)(p.ws + (PH == 2 ? OFF_WT0 : OFF_WT1)); g.M = NTOK; g.N = PH == 2 ? 6400 : 6144; g.K = 1024;
        pg8::StaticOrder S; S.init(g.M, g.N, (int)gridDim.x, (int)blockIdx.x);
        EpiIn E; E.P = Pb; E.DT = (float*)(p.ws + OFF_DT); E.LNP = PH == 2 ? nullptr : (float*)(p.ws + OFF_DT);
        pg8::gemm_phase<EpiIn, pg8::StaticOrder, false>((PG8_LAS unsigned char*)shm, g, S, E, nullptr);
    }
    if constexpr (PH == 3 || PH == 4) {
        const bool bal = gridDim.x == 256;
#ifndef DUP_YUNIT
#define DUP_YUNIT 0
#endif
        for (int u = blockIdx.x; u < 384; u += gridDim.x) { if (PH == 3) sstate_unit(p, shm, u); else { for (int rep_ = 0; rep_ <= DUP_YUNIT; ++rep_) ssd_y_unit(p, shm, u); } }
#ifndef CONF_P3
#define CONF_P3 3
#endif
        if (bal) { if (blockIdx.x >= 128) { const int c0 = ((int)blockIdx.x - 128) * 6 + (PH == 3 ? 0 : CONF_P3); const int nk = PH == 3 ? CONF_P3 : 6 - CONF_P3; for (int k = 0; k < nk; ++k) conformer_unit(p, shm, c0 + k); } }
        else if (PH == 3) { for (int u = gridDim.x - 1 - blockIdx.x; u < 768; u += gridDim.x) conformer_unit(p, shm, u); }
    }
    if constexpr (PH == 5 || PH == 9) {
        pg8::Gemm g; g.A = YC; g.Bt = (const bf16_t*)(p.ws + (PH == 5 ? OFF_WO0 : OFF_WO1)); g.M = NTOK; g.N = 1024; g.K = 2048;
        pg8::StaticOrder S; S.init(g.M, g.N, (int)gridDim.x, (int)blockIdx.x);
        EpiOut E; E.Y = (bf16_t*)(p.ws + OFF_P); E.gate = MODS + (PH == 5 ? 0 : 9 * 3072) + 2048;
        pg8::gemm_phase<EpiOut, pg8::StaticOrder, false>((PG8_LAS unsigned char*)shm, g, S, E, nullptr);
        if (PH == 5 && gridDim.x == 256 && blockIdx.x >= 192) {
            transpose_tiles<2>(p.in[26], (bf16_t*)(p.ws + OFF_WT1), (float*)shm, (int)blockIdx.x - 192, 64);
            transpose_tiles<3>(p.in[31], (bf16_t*)(p.ws + OFF_WO1), (float*)shm, (int)blockIdx.x - 192, 64); }
    }
    if constexpr (PH == 6) ln_phase(p, 0);
    if constexpr (PH == 8) gmlp_phase(p, shm);
    if constexpr (PH == 10) ln_phase(p, 1);
    if constexpr (PH == 11) prefix_phase(p);
}

#ifndef MULTI_LAUNCH
__global__ __launch_bounds__(512, 2) void mega_kernel(Params p) {
    extern __shared__ __attribute__((aligned(16))) unsigned char shm[];
    cg::grid_group grid = cg::this_grid();
    if (p.ws == nullptr) grid.sync();
    volatile LAS unsigned* st = (volatile LAS unsigned*)((LAS unsigned char*)shm + 163824);
    if (threadIdx.x == 0) { st[0] = 0u; st[1] = 0u; st[2] = 0u; st[3] = 0u; }
    __syncthreads();
    unsigned* bar = (unsigned*)(p.ws + OFF_BAR);
    constexpr unsigned kInitWord = XCD_BAR_WORDS + 64, kMagic = 0x600DF00Du;
    if (blockIdx.x == 0) {
        for (int i = threadIdx.x; i < XCD_BAR_WORDS; i += 512) __hip_atomic_store(bar + i, 0u, __ATOMIC_RELAXED, __HIP_MEMORY_SCOPE_AGENT);
        asm volatile("s_waitcnt vmcnt(0)" ::: "memory");
        __syncthreads();
        if (threadIdx.x == 0) { __builtin_amdgcn_fence(__ATOMIC_RELEASE, "agent"); asm volatile("s_waitcnt vmcnt(0)" ::: "memory");
            __hip_atomic_store(bar + kInitWord, kMagic, __ATOMIC_RELAXED, __HIP_MEMORY_SCOPE_AGENT); }
    }
#ifndef REP_MASK
#define REP_MASK 0
#endif
    run_phase<0>(p, shm);
    if (threadIdx.x == 0) { unsigned sp = 0u; while (__hip_atomic_load(bar + kInitWord, __ATOMIC_RELAXED, __HIP_MEMORY_SCOPE_AGENT) != kMagic) { __builtin_amdgcn_s_sleep(1); if (++sp > (1u << 20)) break; }
        __builtin_amdgcn_fence(__ATOMIC_ACQUIRE, "agent"); }
    __syncthreads();
    const XcdBarrier xb = xcd_barrier_post(bar, st);
#define GSYNC() xcd_barrier(xb)
#define RUNP(k) run_phase<k>(p, shm); GSYNC(); if (REP_MASK & (1 << k)) { run_phase<k>(p, shm); GSYNC(); }
    GSYNC();
    if (blockIdx.x == 0 && threadIdx.x == 0) __hip_atomic_store(bar + kInitWord, 0u, __ATOMIC_RELAXED, __HIP_MEMORY_SCOPE_AGENT);
    RUNP(1) RUNP(2) RUNP(3)
    run_phase<11>(p, shm); GSYNC();
    RUNP(4) RUNP(5)
    RUNP(6)
    RUNP(7) RUNP(8)
    run_phase<9>(p, shm); GSYNC();
    run_phase<10>(p, shm);
}
#else
template <int PH> __global__ __launch_bounds__(512, 2) void phase_kernel(Params p) {
    extern __shared__ __attribute__((aligned(16))) unsigned char shm[];
    run_phase<PH>(p, shm);
}
template <int PH> static void launch_phase(const Params& p, hipStream_t stream) {
    hipFuncSetAttribute((const void*)phase_kernel<PH>, hipFuncAttributeMaxDynamicSharedMemorySize, 163840);
    phase_kernel<PH><<<256, 512, 163840, stream>>>(p);
}
#endif

extern "C" void kernel_launch(void* const* d_in, const int* in_sizes, int n_in, void* d_out, int out_size, void* d_ws, size_t ws_size, hipStream_t stream) {
    Params p{};
    for (int i = 0; i < 34; ++i) p.in[i] = (const float*)d_in[i];
    p.out = (float*)d_out; p.ws = (unsigned char*)d_ws;
    constexpr size_t kDynLds = 163840;
#ifndef MULTI_LAUNCH
    static int grid_blocks = 0;
    if (!grid_blocks) {
        int dev = 0, cus = 0, per_cu = 0;
        hipGetDevice(&dev);
        hipDeviceGetAttribute(&cus, hipDeviceAttributeMultiprocessorCount, dev);
        hipFuncSetAttribute((const void*)mega_kernel, hipFuncAttributeMaxDynamicSharedMemorySize, (int)kDynLds);
        hipOccupancyMaxActiveBlocksPerMultiprocessor(&per_cu, mega_kernel, 512, kDynLds);
        if (per_cu < 1) per_cu = 1;
        grid_blocks = cus * (per_cu > 1 ? 1 : per_cu);
    }
    void* args[] = {&p};
    hipError_t e = hipLaunchCooperativeKernel((void*)mega_kernel, dim3(grid_blocks), dim3(512), args, kDynLds, stream);
    if (e != hipSuccess) fprintf(stderr, "cooperative launch failed: %s (grid %d)\n", hipGetErrorString(e), grid_blocks);
#else
    launch_phase<0>(p, stream); launch_phase<1>(p, stream); launch_phase<2>(p, stream); launch_phase<3>(p, stream); launch_phase<11>(p, stream); launch_phase<4>(p, stream); launch_phase<5>(p, stream);
    launch_phase<6>(p, stream); launch_phase<7>(p, stream); launch_phase<8>(p, stream); launch_phase<9>(p, stream); launch_phase<10>(p, stream);
#endif
}
```
